# Optimizing an MI355X kernel written in HIP

```python
import jax, jax.numpy as jnp
from jax import lax
import numpy as np

D_MODEL = 2048
BATCH = 2
SEQ = 8192
DEPTH = 1
DEC_BATCH = 128
DEC_SEQ = 1
PAST_LEN = 16384
PAGE_SIZE = 128

HEAD_DIM = 64
N_Q_HEADS = 16
N_KV_HEADS = 4
GROUP = N_Q_HEADS // N_KV_HEADS
ATTN_WIDTH = N_Q_HEADS * HEAD_DIM
KV_WIDTH = N_KV_HEADS * HEAD_DIM
WINDOW = 128
BLOCK = 128
ROPE_THETA = 500000.0
ROT_DIM = HEAD_DIM // 4
N_RWKV_HEADS = 16
RWKV_WIDTH = N_RWKV_HEADS * HEAD_DIM
DECAY_LORA = 64
ICLR_LORA = 64
GATE_LORA = 160
RWKV_PROJ_WIDTH = 3 * RWKV_WIDTH + DECAY_LORA + ICLR_LORA + GATE_LORA
ATTN_PROJ_WIDTH = ATTN_WIDTH + 2 * KV_WIDTH
IN_WIDTH = ATTN_PROJ_WIDTH + RWKV_PROJ_WIDTH + 2 * D_MODEL
D_FF = 4 * D_MODEL
DEEPNORM_ALPHA = (2.0 * DEPTH) ** 0.25
DEEPNORM_BETA = (8.0 * DEPTH) ** -0.25
LN_EPS = 1e-5
GN_EPS = HEAD_DIM * 1e-5

kernel_name = "hybrid_swa_sink_rwkv7_step"


def _split(t, sizes):
    idx = np.cumsum(sizes)[:-1].tolist()
    return jnp.split(t, idx, axis=-1)


def _layer_norm(x, g, b):
    xf = x.astype(jnp.float32)
    mu = jnp.mean(xf, axis=-1, keepdims=True)
    var = jnp.mean(jnp.square(xf - mu), axis=-1, keepdims=True)
    return ((xf - mu) * lax.rsqrt(var + LN_EPS) * g.astype(jnp.float32) + b.astype(jnp.float32)).astype(x.dtype)


def _rope(x, pos):
    inv = ROPE_THETA ** (-jnp.arange(0, ROT_DIM, 2, dtype=jnp.float32) / ROT_DIM)
    ang = pos.astype(jnp.float32)[:, None] * inv[None, :]
    cos = jnp.cos(ang)[:, None, :]
    sin = jnp.sin(ang)[:, None, :]
    xr = x[..., :ROT_DIM].astype(jnp.float32)
    x1, x2 = xr[..., :ROT_DIM // 2], xr[..., ROT_DIM // 2:]
    rot = jnp.concatenate([x1 * cos - x2 * sin, x2 * cos + x1 * sin], axis=-1).astype(x.dtype)
    return jnp.concatenate([rot, x[..., ROT_DIM:]], axis=-1)


def _sink_attention(q, k, v, q_pos, k_pos, sinks):
    qg = q.reshape(*q.shape[:-2], N_KV_HEADS, GROUP, HEAD_DIM)
    s = jnp.einsum('...qkgd,...skd->...kgqs', qg, k).astype(jnp.float32) * (HEAD_DIM ** -0.5)
    diff = q_pos[..., :, None] - k_pos[..., None, :]
    ok = (diff >= 0) & (diff < WINDOW) & (k_pos[..., None, :] >= 0)
    s = jnp.where(ok[..., None, None, :, :], s, -jnp.inf)
    sink = jnp.broadcast_to(sinks.astype(jnp.float32).reshape(N_KV_HEADS, GROUP, 1, 1), s.shape[:-1] + (1,))
    p = jax.nn.softmax(jnp.concatenate([s, sink], axis=-1), axis=-1)[..., :-1]
    o = jnp.einsum('...kgqs,...skd->...qkgd', p.astype(v.dtype), v)
    return o.reshape(*o.shape[:-3], ATTN_WIDTH)


def _attn_prompt(q, k, v, sinks):
    b, t = q.shape[0], q.shape[1]
    nb = t // BLOCK
    pos = jnp.arange(t, dtype=jnp.int32)
    q = _rope(q, pos)
    k = _rope(k, pos)

    def band(z):
        zb = z.reshape(b, nb, BLOCK, N_KV_HEADS, HEAD_DIM)
        zp = jnp.concatenate([jnp.zeros_like(zb[:, :1]), zb], axis=1)
        return jnp.concatenate([zp[:, :-1], zp[:, 1:]], axis=2)

    qb = q.reshape(b, nb, BLOCK, N_Q_HEADS, HEAD_DIM)
    q_pos = pos.reshape(nb, BLOCK)
    k_pos = (jnp.arange(nb, dtype=jnp.int32)[:, None] - 1) * BLOCK + jnp.arange(2 * BLOCK, dtype=jnp.int32)[None, :]
    o = _sink_attention(qb, band(k), band(v), q_pos, k_pos, sinks)
    win = min(WINDOW, t)
    return o.reshape(b, t, ATTN_WIDTH), k[:, t - win:], v[:, t - win:]


def _attn_sample(q, k, v, k_cache, v_cache, sinks):
    b, t = q.shape[0], q.shape[1]
    win = k_cache.shape[1]
    q_pos = PAST_LEN + jnp.arange(t, dtype=jnp.int32)
    q = _rope(q, q_pos)
    k = _rope(k, q_pos)
    kk = jnp.concatenate([k_cache, k], axis=1)
    vv = jnp.concatenate([v_cache, v], axis=1)
    k_pos = jnp.concatenate([PAST_LEN - win + jnp.arange(win, dtype=jnp.int32), q_pos])
    o = _sink_attention(q, kk, vv, q_pos, k_pos, sinks)
    return o.reshape(b, t, ATTN_WIDTH), kk[:, t:], vv[:, t:]


def _wkv7_scan(r, w, k, v, a, bb, s0):
    xs = tuple(jnp.moveaxis(z, 1, 0) for z in (r, w, k, v, a, bb))

    def step(S, inp):
        r_t, w_t, k_t, v_t, a_t, b_t = inp
        sa = jnp.einsum('bhij,bhj->bhi', S, a_t)
        S = S * w_t[:, :, None, :] + sa[..., None] * b_t[:, :, None, :] + v_t[..., None] * k_t[:, :, None, :]
        return S, jnp.einsum('bhij,bhj->bhi', S, r_t)

    S, ys = lax.scan(step, s0.astype(jnp.float32), xs)
    return jnp.moveaxis(ys, 0, 1), S


def _rwkv7_branch(p, p_last, wkv0, w):
    b, t, _ = p.shape
    prev = jnp.concatenate([p_last[:, None, :].astype(p.dtype), p[:, :-1]], axis=1)
    ps = (p + (prev - p) * w['mu_shift']).astype(jnp.float32)
    r, k, v, wd, ad, gd = _split(ps, (RWKV_WIDTH, RWKV_WIDTH, RWKV_WIDTH, DECAY_LORA, ICLR_LORA, GATE_LORA))
    f32 = lambda z: z.astype(jnp.float32)
    w_log = -jax.nn.softplus(-(f32(w['w0']) + jnp.tanh(wd) @ f32(w['w_decay_up']))) - 0.5
    decay = jnp.exp(-jnp.exp(w_log))
    a = jax.nn.sigmoid(f32(w['a0']) + ad @ f32(w['w_iclr_up']))
    g = jax.nn.sigmoid(gd) @ f32(w['w_gate_up'])
    heads = lambda z: z.reshape(b, t, N_RWKV_HEADS, HEAD_DIM)
    kk = heads(k * f32(w['k_k']))
    kk = kk / jnp.maximum(jnp.sqrt(jnp.sum(kk * kk, axis=-1, keepdims=True)), 1e-12)
    k = k * (1.0 + (a - 1.0) * f32(w['k_a']))
    rh, kh, vh, ah = heads(r), heads(k), heads(v), heads(a)
    y, s_new = _wkv7_scan(rh, heads(decay), kh, vh, -kk, kk * ah, wkv0)
    mu = jnp.mean(y, axis=-1, keepdims=True)
    var = jnp.mean(jnp.square(y - mu), axis=-1, keepdims=True)
    yn = ((y - mu) * lax.rsqrt(var + GN_EPS)).reshape(b, t, RWKV_WIDTH) * f32(w['gn_w']) + f32(w['gn_b'])
    bonus = jnp.sum(rh * kh * f32(w['r_k']).reshape(N_RWKV_HEADS, HEAD_DIM), axis=-1, keepdims=True) * vh
    out = (yn + bonus.reshape(b, t, RWKV_WIDTH)) * g
    return out.astype(p.dtype), p[:, -1], s_new.astype(wkv0.dtype)


def _trunk_layer(x, attn_fn, p_last, wkv0, w):
    b, t, _ = x.shape
    p = x @ w['w_in']
    p_attn, p_rwkv, p_gate = _split(p, (ATTN_PROJ_WIDTH, RWKV_PROJ_WIDTH, 2 * D_MODEL))
    q, k, v = _split(p_attn, (ATTN_WIDTH, KV_WIDTH, KV_WIDTH))
    gate_a, gate_b = _split(p_gate, (D_MODEL, D_MODEL))
    attn_o, k_buf, v_buf = attn_fn(q.reshape(b, t, N_Q_HEADS, HEAD_DIM),
                                   k.reshape(b, t, N_KV_HEADS, HEAD_DIM),
                                   v.reshape(b, t, N_KV_HEADS, HEAD_DIM))
    rwkv_o, shift_new, wkv_new = _rwkv7_branch(p_rwkv, p_last, wkv0, w)
    merged = (jax.nn.sigmoid(gate_a) * (attn_o @ w['w_proj_attn'])
              + jax.nn.sigmoid(gate_b) * (rwkv_o @ w['w_proj_rwkv'])) @ w['w_out']
    h = _layer_norm(DEEPNORM_ALPHA * x + merged, w['ln1_g'], w['ln1_b'])
    f = jnp.square(jax.nn.relu(h @ w['w_up'])) @ w['w_down']
    y = _layer_norm(DEEPNORM_ALPHA * h + f, w['ln2_g'], w['ln2_b'])
    return y, k_buf, v_buf, shift_new, wkv_new


def setup_inputs(seed: int = 0) -> dict:
    key = jax.random.key(seed)
    ks = jax.random.split(key, 32)
    nrm = lambda kk, shape, sc: jax.random.normal(kk, shape, jnp.float32) * sc
    L = DEPTH
    win_buf = min(WINDOW, PAST_LEN)
    return {
        'x_prompt': nrm(ks[0], (BATCH, SEQ, D_MODEL), 1.0),
        'x_sample': nrm(ks[1], (DEC_BATCH, DEC_SEQ, D_MODEL), 1.0),
        'cache_k_win': nrm(ks[2], (L, DEC_BATCH, win_buf, N_KV_HEADS, HEAD_DIM), 1.0),
        'cache_v_win': nrm(ks[3], (L, DEC_BATCH, win_buf, N_KV_HEADS, HEAD_DIM), 1.0),
        'state_shift': nrm(ks[4], (L, DEC_BATCH, RWKV_PROJ_WIDTH), 1.0),
        'state_wkv': nrm(ks[5], (L, DEC_BATCH, N_RWKV_HEADS, HEAD_DIM, HEAD_DIM), 1.0),
        'w_in': nrm(ks[6], (L, D_MODEL, IN_WIDTH), D_MODEL ** -0.5),
        'attn_sinks': nrm(ks[7], (L, N_Q_HEADS), 0.5),
        'mu_shift': jax.random.uniform(ks[8], (L, RWKV_PROJ_WIDTH), jnp.float32, 0.0, 1.0),
        'w0': jax.random.uniform(ks[9], (L, RWKV_WIDTH), jnp.float32, -2.0, 1.0),
        'w_decay_up': nrm(ks[10], (L, DECAY_LORA, RWKV_WIDTH), 0.1 * DECAY_LORA ** -0.5),
        'a0': nrm(ks[11], (L, RWKV_WIDTH), 0.1),
        'w_iclr_up': nrm(ks[12], (L, ICLR_LORA, RWKV_WIDTH), 0.1 * ICLR_LORA ** -0.5),
        'w_gate_up': nrm(ks[13], (L, GATE_LORA, RWKV_WIDTH), GATE_LORA ** -0.5),
        'k_k': 0.85 + nrm(ks[14], (L, RWKV_WIDTH), 0.05),
        'k_a': 1.0 + nrm(ks[15], (L, RWKV_WIDTH), 0.05),
        'r_k': nrm(ks[16], (L, RWKV_WIDTH), 0.1),
        'gn_w': 1.0 + nrm(ks[17], (L, RWKV_WIDTH), 0.05),
        'gn_b': nrm(ks[18], (L, RWKV_WIDTH), 0.01),
        'w_proj_attn': nrm(ks[19], (L, ATTN_WIDTH, D_MODEL), DEEPNORM_BETA * ATTN_WIDTH ** -0.5),
        'w_proj_rwkv': nrm(ks[20], (L, RWKV_WIDTH, D_MODEL), DEEPNORM_BETA * RWKV_WIDTH ** -0.5),
        'w_out': nrm(ks[21], (L, D_MODEL, D_MODEL), DEEPNORM_BETA * D_MODEL ** -0.5),
        'ln1_g': 1.0 + nrm(ks[22], (L, D_MODEL), 0.05),
        'ln1_b': nrm(ks[23], (L, D_MODEL), 0.01),
        'w_up': nrm(ks[24], (L, D_MODEL, D_FF), D_MODEL ** -0.5),
        'w_down': nrm(ks[25], (L, D_FF, D_MODEL), DEEPNORM_BETA * D_FF ** -0.5),
        'ln2_g': 1.0 + nrm(ks[26], (L, D_MODEL), 0.05),
        'ln2_b': nrm(ks[27], (L, D_MODEL), 0.01),
    }


def reference(x_prompt, x_sample, cache_k_win, cache_v_win, state_shift, state_wkv,
              w_in, attn_sinks, mu_shift, w0, w_decay_up, a0, w_iclr_up, w_gate_up,
              k_k, k_a, r_k, gn_w, gn_b, w_proj_attn, w_proj_rwkv, w_out,
              ln1_g, ln1_b, w_up, w_down, ln2_g, ln2_b):
    params = {
        'w_in': w_in, 'attn_sinks': attn_sinks, 'mu_shift': mu_shift, 'w0': w0,
        'w_decay_up': w_decay_up, 'a0': a0, 'w_iclr_up': w_iclr_up, 'w_gate_up': w_gate_up,
        'k_k': k_k, 'k_a': k_a, 'r_k': r_k, 'gn_w': gn_w, 'gn_b': gn_b,
        'w_proj_attn': w_proj_attn, 'w_proj_rwkv': w_proj_rwkv, 'w_out': w_out,
        'ln1_g': ln1_g, 'ln1_b': ln1_b, 'w_up': w_up, 'w_down': w_down,
        'ln2_g': ln2_g, 'ln2_b': ln2_b,
    }
    b = x_prompt.shape[0]
    hp, hs = x_prompt, x_sample
    kp_l, vp_l, sp_l, wp_l, ks_l, vs_l, ss_l, ws_l = [], [], [], [], [], [], [], []
    for l in range(DEPTH):
        w = {name: arr[l] for name, arr in params.items()}
        sinks = w['attn_sinks']
        hp, kp, vp, sp, wp = _trunk_layer(
            hp, lambda q, k, v: _attn_prompt(q, k, v, sinks),
            jnp.zeros((b, RWKV_PROJ_WIDTH), x_prompt.dtype),
            jnp.zeros((b, N_RWKV_HEADS, HEAD_DIM, HEAD_DIM), state_wkv.dtype), w)
        kc, vc = cache_k_win[l], cache_v_win[l]
        hs, kn, vn, sn, wn = _trunk_layer(
            hs, lambda q, k, v: _attn_sample(q, k, v, kc, vc, sinks),
            state_shift[l], state_wkv[l], w)
        kp_l.append(kp); vp_l.append(vp); sp_l.append(sp); wp_l.append(wp)
        ks_l.append(kn); vs_l.append(vn); ss_l.append(sn); ws_l.append(wn)
    return (hp, hs,
            jnp.stack(kp_l), jnp.stack(vp_l), jnp.stack(sp_l), jnp.stack(wp_l),
            jnp.stack(ks_l), jnp.stack(vs_l), jnp.stack(ss_l), jnp.stack(ws_l))
```

```cpp
#include <hip/hip_runtime.h>
#include <hip/hip_cooperative_groups.h>
#include <cstdio>
#include <cstdint>
namespace cg = cooperative_groups;
__device__ __forceinline__ int otid() { int t = threadIdx.x; asm volatile("" : "+v"(t)); return t; }
namespace pg8 {
#define PG8_LAS __attribute__((address_space(3)))
typedef unsigned short bf16_t;
typedef short bf16x8 __attribute__((ext_vector_type(8)));
typedef float f32x4 __attribute__((ext_vector_type(4)));
typedef unsigned u32x4 __attribute__((ext_vector_type(4)));
constexpr int BM = 256, BK = 64, HALF = 128, HTB = HALF * BK * 2  , STAGE_BYTES = 8 * HTB, NXCD = 8, WGM = 4;

__host__ __device__ __forceinline__ int lds_byte(int r, int c) { const int st = (r >> 4) * 2 + (c >> 5), rr = r & 15, cc = c & 31, ob = rr * 64 + cc * 2; return st * 1024 + (ob ^ (((ob >> 9) & 1) << 5)); }
__host__ __device__ __forceinline__ void stage_rc(int b, int& R, int& C) { const int st = b / 1024, sb = b % 1024, swz = sb ^ (((sb >> 9) & 1) << 5); R = (st >> 1) * 16 + swz / 64; C = (st & 1) * 32 + (swz % 64) / 2; }
__host__ __device__ __forceinline__ int perm32(int rho) { const int n = rho >> 4, i = rho & 15; return 8 * (i >> 2) + 4 * n + (i & 3); }

struct Unit { int pm, pn, slot; long offA, offB; };
struct Gemm { const bf16_t* A; const bf16_t* Bt; int M, N, K, lda, ldb; };

struct StaticOrder {
    int nM, nN, nwg, G, c, wgm;
    __host__ __device__ void init(int M, int N, int G_, int c_, int wgm_ = WGM) { nM = M / BM; nN = N / BM; nwg = nM * nN; G = G_; c = c_; wgm = wgm_; }
    __host__ __device__ bool next(int i, Unit& u) const {
        const long L = (long)i * G + c; if (L >= nwg) return false;
        int wgid = (int)L; { const int q = nwg / NXCD, r = nwg % NXCD, xcd = wgid % NXCD, off = wgid / NXCD; wgid = (xcd < r ? xcd * (q + 1) : r * (q + 1) + (xcd - r) * q) + off; }
        const int nig = wgm * nN, gid = wgid / nig, fm = gid * wgm, gsz = (nM - fm) < wgm ? (nM - fm) : wgm;
        u.pm = fm + ((wgid % nig) % gsz); u.pn = (wgid % nig) / gsz; u.slot = 0; u.offA = 0; u.offB = 0; return true;
    }
    __device__ __forceinline__ void a_ready(const Unit&) const {}
    __device__ __forceinline__ void done(const Unit&) const {}
};
template <class Epi, class Sched, bool ALIGN_EPI = false, bool SP2 = false>
__device__ __forceinline__ void gemm_phase(PG8_LAS unsigned char* lds, const Gemm g, const Sched& S, const Epi& E) {
    const int tid = otid(), wid = __builtin_amdgcn_readfirstlane(tid >> 6), lane = tid & 63, wr = wid >> 2, wc = wid & 3, fr = lane & 15, fq = lane >> 4;
    const int K = g.K, nt = K / BK;
    unsigned voffA[2], voffB[2];
#pragma unroll
    for (int i = 0; i < 2; ++i) { int R, C; stage_rc(tid * 16 + i * 8192, R, C); const int Rb = Epi::PERM ? ((R & ~31) + perm32(R & 31)) : R;
        voffA[i] = (unsigned)(R * g.lda + C) * 2u; voffB[i] = (unsigned)(Rb * g.ldb + C) * 2u; }
    const size_t kstep = (size_t)(BK * 2);
    const size_t hstepA = (size_t)HALF * g.lda * 2, hstepB = (size_t)HALF * g.ldb * 2;
    const size_t tstepA = 2 * hstepA, tstepB = 2 * hstepB;
    const unsigned ldsw = (unsigned)wid * 1024u;
    const int aoff = lds_byte(wr * 64 + fr, fq * 8), boff = lds_byte(wc * 32 + fr, fq * 8);
#define PG8_SA(b, h) (((b) * 2 + (h)) * HTB)
#define PG8_SB(b, h) ((4 + (b) * 2 + (h)) * HTB)
#define PG8_STAGE(bufoff, gbase, voff) do { _Pragma("unroll") for (int _i = 0; _i < 2; ++_i) \
        __builtin_amdgcn_global_load_lds((const unsigned*)((const char*)(gbase) + (voff)[_i]), (PG8_LAS unsigned*)(lds + (bufoff) + ldsw + _i * 8192), 16, 0, 0); } while (0)
#define PG8_LDA(dst, b, h) do { _Pragma("unroll") for (int m = 0; m < 4; ++m) _Pragma("unroll") for (int k = 0; k < 2; ++k) dst[m][k] = *(const PG8_LAS bf16x8*)(lds + PG8_SA(b, h) + aoff + m * 2048 + k * 1024); } while (0)
#define PG8_LDB(dst, b, h) do { _Pragma("unroll") for (int n = 0; n < 2; ++n) _Pragma("unroll") for (int k = 0; k < 2; ++k) dst[n][k] = *(const PG8_LAS bf16x8*)(lds + PG8_SB(b, h) + boff + n * 2048 + k * 1024); } while (0)
#define PG8_MMA(ai, bj, At, Bt) do { __builtin_amdgcn_s_setprio(1); _Pragma("unroll") for (int m = 0; m < 4; ++m) _Pragma("unroll") for (int n = 0; n < 2; ++n) _Pragma("unroll") for (int k = 0; k < 2; ++k) \
        acc[ai][bj][m][n] = __builtin_amdgcn_mfma_f32_16x16x32_bf16(Bt[n][k], At[m][k], acc[ai][bj][m][n], 0, 0, 0); __builtin_amdgcn_s_setprio(0); } while (0)
#define PG8_WAIT_V(n) asm volatile("s_waitcnt vmcnt(" #n ")" ::: "memory")
#define PG8_WAIT_L(n) asm volatile("s_waitcnt lgkmcnt(" #n ")" ::: "memory")
#define PG8_BAR __builtin_amdgcn_s_barrier()
#define PG8_SCHED __builtin_amdgcn_sched_barrier(0)
    Unit cur, nxt; int ui = 0;
    if (!S.next(0, cur)) return;
    f32x4 acc[2][2][4][2];
#pragma unroll
    for (int a = 0; a < 2; ++a)
#pragma unroll
        for (int b = 0; b < 2; ++b)
#pragma unroll
            for (int m = 0; m < 4; ++m)
#pragma unroll
                for (int n = 0; n < 2; ++n) acc[a][b][m][n] = (f32x4){0.f, 0.f, 0.f, 0.f};
    bf16x8 At[4][2], B0[2][2], B1[2][2];
    const char* cA = (const char*)g.A + (size_t)cur.pm * tstepA + cur.offA; const char* cB = (const char*)g.Bt + (size_t)cur.pn * tstepB + cur.offB;
    S.a_ready(cur);
    if constexpr (SP2) {
        PG8_STAGE(PG8_SB(0, 0), cB, voffB); PG8_STAGE(PG8_SB(0, 1), cB + hstepB, voffB); PG8_STAGE(PG8_SA(0, 0), cA, voffA); PG8_STAGE(PG8_SA(0, 1), cA + hstepA, voffA);
        if (wr == 1) PG8_BAR;
        PG8_WAIT_V(2); PG8_BAR;
        PG8_STAGE(PG8_SB(1, 0), cB + kstep, voffB); PG8_STAGE(PG8_SA(1, 0), cA + kstep, voffA); PG8_STAGE(PG8_SB(1, 1), cB + hstepB + kstep, voffB);
        PG8_WAIT_V(6); PG8_BAR;
    } else {
        PG8_STAGE(PG8_SB(0, 0), cB, voffB); PG8_STAGE(PG8_SA(0, 0), cA, voffA); PG8_STAGE(PG8_SB(0, 1), cB + hstepB, voffB); PG8_STAGE(PG8_SA(0, 1), cA + hstepA, voffA);
        if (wr == 1) PG8_BAR;
        PG8_WAIT_V(4); PG8_BAR;
        PG8_STAGE(PG8_SB(1, 0), cB + kstep, voffB); PG8_STAGE(PG8_SA(1, 0), cA + kstep, voffA); PG8_STAGE(PG8_SB(1, 1), cB + hstepB + kstep, voffB);
        PG8_WAIT_V(6); PG8_BAR;
    }
    for (;;) {
        const bool has_next = S.next(ui + 1, nxt);
        const char* nA = has_next ? (const char*)g.A + (size_t)nxt.pm * tstepA + nxt.offA : cA; const char* nB = has_next ? (const char*)g.Bt + (size_t)nxt.pn * tstepB + nxt.offB : cB;
        for (int t = 0; t < nt; t += 2) {
            const bool last = (t == nt - 2);
            const char* a1 = cA + (size_t)(t + 1) * kstep;
            const char* a2 = last ? nA : cA + (size_t)(t + 2) * kstep; const char* b2 = last ? nB : cB + (size_t)(t + 2) * kstep;
            const char* a3 = a2 + kstep; const char* b3 = b2 + kstep;
            if (last && has_next) S.a_ready(nxt);
            if constexpr (SP2) {
            PG8_LDB(B0, 0, 0); PG8_LDB(B1, 0, 1); PG8_SCHED; PG8_LDA(At, 0, 0); PG8_STAGE(PG8_SA(1, 1), a1 + hstepA, voffA);
            PG8_WAIT_V(8); PG8_WAIT_L(0); PG8_BAR; PG8_MMA(0, 0, At, B0); PG8_MMA(0, 1, At, B1); PG8_BAR; PG8_SCHED;
            PG8_LDA(At, 0, 1); PG8_STAGE(PG8_SB(0, 0), b2, voffB); PG8_STAGE(PG8_SB(0, 1), b2 + hstepB, voffB); PG8_STAGE(PG8_SA(0, 0), a2, voffA);
            PG8_WAIT_V(8); PG8_WAIT_L(0); PG8_BAR; PG8_MMA(1, 0, At, B0); PG8_MMA(1, 1, At, B1); PG8_BAR; PG8_SCHED;
            PG8_LDB(B0, 1, 0); PG8_LDB(B1, 1, 1); PG8_SCHED; PG8_LDA(At, 1, 0); PG8_STAGE(PG8_SA(0, 1), a2 + hstepA, voffA);
            PG8_WAIT_V(8); PG8_WAIT_L(0); PG8_BAR; PG8_MMA(0, 0, At, B0); PG8_MMA(0, 1, At, B1); PG8_BAR; PG8_SCHED;
            PG8_LDA(At, 1, 1); PG8_STAGE(PG8_SB(1, 0), b3, voffB); PG8_STAGE(PG8_SB(1, 1), b3 + hstepB, voffB); PG8_STAGE(PG8_SA(1, 0), a3, voffA);
            PG8_WAIT_V(8); PG8_WAIT_L(0); PG8_BAR; PG8_MMA(1, 0, At, B0); PG8_MMA(1, 1, At, B1); PG8_BAR; PG8_SCHED;
            } else {
            PG8_LDB(B0, 0, 0); PG8_SCHED; PG8_LDA(At, 0, 0); PG8_STAGE(PG8_SA(1, 1), a1 + hstepA, voffA);
            PG8_WAIT_L(8); PG8_BAR; PG8_WAIT_L(0); PG8_MMA(0, 0, At, B0); PG8_BAR; PG8_SCHED;
            PG8_LDB(B1, 0, 1); PG8_STAGE(PG8_SB(0, 0), b2, voffB);
            PG8_BAR; PG8_WAIT_L(0); PG8_MMA(0, 1, At, B1); PG8_BAR;
            PG8_LDA(At, 0, 1); PG8_STAGE(PG8_SA(0, 0), a2, voffA);
            PG8_BAR; PG8_WAIT_L(0); PG8_MMA(1, 0, At, B0); PG8_BAR; PG8_SCHED;
            PG8_STAGE(PG8_SB(0, 1), b2 + hstepB, voffB);
            PG8_WAIT_V(6); PG8_BAR; PG8_MMA(1, 1, At, B1); PG8_BAR;
            PG8_LDB(B0, 1, 0); PG8_SCHED; PG8_LDA(At, 1, 0); PG8_STAGE(PG8_SA(0, 1), a2 + hstepA, voffA);
            PG8_WAIT_L(8); PG8_BAR; PG8_WAIT_L(0); PG8_MMA(0, 0, At, B0); PG8_BAR; PG8_SCHED;
            PG8_LDB(B1, 1, 1); PG8_STAGE(PG8_SB(1, 0), b3, voffB);
            PG8_BAR; PG8_WAIT_L(0); PG8_MMA(0, 1, At, B1); PG8_BAR;
            PG8_LDA(At, 1, 1); PG8_STAGE(PG8_SA(1, 0), a3, voffA);
            PG8_BAR; PG8_WAIT_L(0); PG8_MMA(1, 0, At, B0); PG8_BAR; PG8_SCHED;
            PG8_STAGE(PG8_SB(1, 1), b3 + hstepB, voffB);
            PG8_WAIT_V(6); PG8_BAR; PG8_MMA(1, 1, At, B1); PG8_BAR;
            }
        }
        if constexpr (ALIGN_EPI) { if (wr == 0) PG8_BAR; }
        if constexpr (!Epi::AFTER_DRAIN) { E(acc, cur, wr, wc, fr, fq); S.done(cur); }
        if (!has_next) break;
#pragma unroll
        for (int a = 0; a < 2; ++a)
#pragma unroll
            for (int b = 0; b < 2; ++b)
#pragma unroll
                for (int m = 0; m < 4; ++m)
#pragma unroll
                    for (int n = 0; n < 2; ++n) acc[a][b][m][n] = (f32x4){0.f, 0.f, 0.f, 0.f};
        cur = nxt; cA = nA; cB = nB; ++ui;
        if constexpr (ALIGN_EPI) { if (wr == 1) PG8_BAR; }
    }
    PG8_WAIT_V(0);
    if constexpr (!ALIGN_EPI) { if (wr == 0) PG8_BAR; }
    PG8_BAR;
    if constexpr (Epi::AFTER_DRAIN) { E.fused(acc, cur, wr, wc, fr, fq, lds, wid, lane); S.done(cur); }
#undef PG8_SA
#undef PG8_SB
#undef PG8_STAGE
#undef PG8_LDA
#undef PG8_LDB
#undef PG8_MMA
#undef PG8_WAIT_V
#undef PG8_WAIT_L
#undef PG8_BAR
#undef PG8_SCHED
}
}

typedef unsigned short bf16_t;
typedef short bf16x8 __attribute__((ext_vector_type(8)));
typedef short bf16x4 __attribute__((ext_vector_type(4)));
typedef float f32x4 __attribute__((ext_vector_type(4)));
typedef float f32x2 __attribute__((ext_vector_type(2)));
typedef unsigned u32x4 __attribute__((ext_vector_type(4)));
typedef unsigned u32x2 __attribute__((ext_vector_type(2)));

constexpr int DM = 2048, SEQ = 8192, NBATCH = 2, MP = NBATCH * SEQ, MS = 128, MREAL = MP + MS, MPAD = 16640;
constexpr int INW = 8992, LDP = 9216, DFF = 8192, AW = 1024;
constexpr int COL_Q = 0, COL_K = 1024, COL_V = 1280, COL_R = 1536, COL_RK = 2560, COL_RV = 3584, COL_WD = 4608, COL_AD = 4672, COL_GD = 4736, COL_GA = 4896, COL_GB = 6944;
constexpr int RW = 3360;
constexpr int NCH = 16, CHUNK = 512, SUB = 32;
constexpr float ALPHA = 1.189207115002721f;
constexpr float LN_EPS = 1e-5f, GN_EPS = 64e-5f;
constexpr int PAST_LEN = 16384;

constexpr size_t MiB = 1u << 20;
constexpr size_t WS_WIN = 1 * MiB, WS_PU = 1 * MiB, WS_WPA = 37 * MiB, WS_WPR = 41 * MiB, WS_WOUT = 45 * MiB, WS_WUP = 53 * MiB, WS_WDN = 85 * MiB, WS_LORA = 117 * MiB;
constexpr size_t WS_A = 118 * MiB, WS_RWO = WS_A + (size_t)MPAD * AW * 2, WS_P = 183 * MiB, WS_SC = 476 * MiB, WS_PB = 484 * MiB, WS_END = 512 * MiB;
static_assert(WS_A + (size_t)MPAD * DM * 2 <= WS_P && WS_P + (size_t)MPAD * LDP * 2 <= WS_SC, "ws map");
constexpr size_t O_YP = 0, O_YS = 33554432, O_KWP = 33816576, O_VWP = 33882112, O_SHP = 33947648, O_WKVP = 33954368, O_KWS = 34085440, O_VWS = 38279744, O_SHS = 42474048, O_WKVS = 42904128, O_END = 51292736;

constexpr int LDS_BYTES = 147456;
constexpr int NTHREADS = 512;

struct Params { const float* in[28]; float* out; unsigned char* ws; };
#ifndef DBL_MASK
#define DBL_MASK 0
#endif
#define REP(k) _Pragma("unroll") for (int rep_ = 0; rep_ < (((DBL_MASK) >> (k)) & 1) + 1; ++rep_)

typedef __bf16 bf16x2_t __attribute__((ext_vector_type(2)));
__device__ __forceinline__ unsigned pk2s(float lo, float hi) { const f32x2 v = {lo, hi}; const bf16x2_t bb = __builtin_convertvector(v, bf16x2_t); return __builtin_bit_cast(unsigned, bb); }
__device__ __forceinline__ unsigned pk2(float lo, float hi) { unsigned r; asm volatile("v_cvt_pk_bf16_f32 %0, %1, %2" : "=v"(r) : "v"(lo), "v"(hi)); return r; }
__device__ __forceinline__ float bf2f(unsigned short b) { return __uint_as_float(((unsigned)b) << 16); }
__device__ __forceinline__ float bflo(unsigned w) { return __uint_as_float(w << 16); }
__device__ __forceinline__ float bfhi(unsigned w) { return __uint_as_float(w & 0xffff0000u); }
__device__ __forceinline__ float sigmoidf_(float x) { return __builtin_amdgcn_rcpf(1.0f + __expf(-x)); }
__device__ __forceinline__ float wave_sum(float v) {
#pragma unroll
    for (int o = 1; o < 64; o <<= 1) v += __shfl_xor(v, o);
    return v;
}
__device__ __forceinline__ float dpp_f(float x, const int ctrl_sel) {
    int v = __float_as_int(x), r;
    if (ctrl_sel == 0) r = __builtin_amdgcn_update_dpp(0, v, 0xB1, 0xF, 0xF, true);
    else if (ctrl_sel == 1) r = __builtin_amdgcn_update_dpp(0, v, 0x4E, 0xF, 0xF, true);
    else r = __builtin_amdgcn_update_dpp(0, v, 0x141, 0xF, 0xF, true);
    return __int_as_float(r);
}
__device__ __forceinline__ float red8(float x) { x += dpp_f(x, 0); x += dpp_f(x, 1); x += dpp_f(x, 2); return x; }

namespace pg8 {

struct EpiP {
    static constexpr bool PERM = true, AFTER_DRAIN = false;
    bf16_t* P;
    __device__ __forceinline__ void operator()(const f32x4 (&acc)[2][2][4][2], const Unit& u, int wr, int wc, int fr, int fq) const {
        const int row0 = u.pm * BM + wr * 64 + fr;
        const int colt = u.pn * BM + wc * 32 + 8 * fq;
        const bool ropet = (u.pn < 5) && ((wc & 1) == 0);
        const float qs = (u.pn < 4) ? 0.125f : 1.0f;
        const float INV[8] = {1.0f, 0.1939227432012558f, 0.03760603070259094f, 0.007292664609849453f, 0.0014142135623842478f, 0.00027424818836152554f, 5.318296098266728e-05f, 1.0313386155758053e-05f};
#pragma unroll
        for (int ai = 0; ai < 2; ++ai)
#pragma unroll
            for (int m = 0; m < 4; ++m) {
                const int row = row0 + ai * HALF + m * 16;
                float cs[8], sn[8];
                if (ropet) {
                    const int pos = (row < MP) ? (row & (SEQ - 1)) : PAST_LEN;
#pragma unroll
                    for (int i = 0; i < 8; ++i) {
                        const float ang = (float)pos * INV[i];
                        double rev = (double)ang * 0.15915494309189535; rev -= __builtin_rint(rev);
                        const float rf = (float)rev;
                        cs[i] = __builtin_amdgcn_cosf(rf); sn[i] = __builtin_amdgcn_sinf(rf);
                    }
                }
                bf16_t* rowp = P + (size_t)row * LDP + colt;
#pragma unroll
                for (int bj = 0; bj < 2; ++bj) {
                    const f32x4 v0 = acc[ai][bj][m][0], v1 = acc[ai][bj][m][1];
                    float x[8] = {v0[0], v0[1], v0[2], v0[3], v1[0], v1[1], v1[2], v1[3]};
                    if (ropet) {
#pragma unroll
                        for (int i = 0; i < 8; ++i) {
                            const float other = __shfl_xor(x[i], 16);
                            const float rot = (fq == 0) ? (x[i] * cs[i] - other * sn[i]) : (x[i] * cs[i] + other * sn[i]);
                            x[i] = (fq < 2) ? rot : x[i];
                        }
                    }
                    const int col = colt + bj * HALF;
                    if (col >= COL_GA) {
#pragma unroll
                        for (int i = 0; i < 8; ++i) x[i] = sigmoidf_(x[i]);
                    }
                    u32x4 w; w.x = pk2(x[0] * qs, x[1] * qs); w.y = pk2(x[2] * qs, x[3] * qs); w.z = pk2(x[4] * qs, x[5] * qs); w.w = pk2(x[6] * qs, x[7] * qs);
                    *(u32x4*)(rowp + bj * HALF) = w;
                }
            }
    }
};

struct EpiGateA {
    static constexpr bool PERM = false, AFTER_DRAIN = false;
    bf16_t* P; float* U;
    __device__ __forceinline__ void operator()(const f32x4 (&acc)[2][2][4][2], const Unit& u, int wr, int wc, int fr, int fq) const {
        const int row0 = u.pm * BM + wr * 64 + fr, col0 = u.pn * BM + wc * 32 + 4 * fq;
#pragma unroll
        for (int ai = 0; ai < 2; ++ai)
#pragma unroll
            for (int m = 0; m < 4; ++m) {
                const int row = row0 + ai * HALF + m * 16;
                if (row < MREAL) {
#pragma unroll
                    for (int bj = 0; bj < 2; ++bj)
#pragma unroll
                        for (int n = 0; n < 2; ++n) {
                            const int col = col0 + bj * HALF + n * 16;
                            const u32x2 gw = *(const u32x2*)(P + (size_t)row * LDP + COL_GA + col);
                            const f32x4 a = acc[ai][bj][m][n];
                            u32x2 o; o.x = pk2(a[0] * bflo(gw.x), a[1] * bfhi(gw.x)); o.y = pk2(a[2] * bflo(gw.y), a[3] * bfhi(gw.y));
                            *(u32x2*)(P + (size_t)row * LDP + COL_GA + col) = o;
                        }
                }
            }
    }
};
struct EpiGateB {
    static constexpr bool PERM = false, AFTER_DRAIN = false;
    bf16_t* P; const float* U;
    __device__ __forceinline__ void operator()(const f32x4 (&acc)[2][2][4][2], const Unit& u, int wr, int wc, int fr, int fq) const {
        const int row0 = u.pm * BM + wr * 64 + fr, col0 = u.pn * BM + wc * 32 + 4 * fq;
#pragma unroll
        for (int ai = 0; ai < 2; ++ai)
#pragma unroll
            for (int m = 0; m < 4; ++m) {
                const int row = row0 + ai * HALF + m * 16;
                if (row < MREAL) {
#pragma unroll
                    for (int bj = 0; bj < 2; ++bj)
#pragma unroll
                        for (int n = 0; n < 2; ++n) {
                            const int col = col0 + bj * HALF + n * 16;
                            const u32x2 gw = *(const u32x2*)(P + (size_t)row * LDP + COL_GB + col);
                            const f32x4 a = acc[ai][bj][m][n];
                            const u32x2 uw = *(const u32x2*)(P + (size_t)row * LDP + COL_GA + col);
                            u32x2 o; o.x = pk2(bflo(uw.x) + a[0] * bflo(gw.x), bfhi(uw.x) + a[1] * bfhi(gw.x)); o.y = pk2(bflo(uw.y) + a[2] * bflo(gw.y), bfhi(uw.y) + a[3] * bfhi(gw.y));
                            *(u32x2*)(P + (size_t)row * LDP + COL_GA + col) = o;
                        }
                }
            }
    }
};
struct EpiResid {
    static constexpr bool PERM = false, AFTER_DRAIN = false;
    const float* xp; const float* xs; float* Z; const bf16_t* hb;
    __device__ __forceinline__ void operator()(const f32x4 (&acc)[2][2][4][2], const Unit& u, int wr, int wc, int fr, int fq) const {
        const int row0 = u.pm * BM + wr * 64 + fr, col0 = u.pn * BM + wc * 32 + 4 * fq;
#pragma unroll
        for (int ai = 0; ai < 2; ++ai)
#pragma unroll
            for (int m = 0; m < 4; ++m) {
                const int row = row0 + ai * HALF + m * 16;
                if (row < MREAL) {
                    const float* bp = xp ? ((row < MP) ? xp + (size_t)row * DM : xs + (size_t)(row - MP) * DM) : Z + (size_t)row * DM;
#pragma unroll
                    for (int bj = 0; bj < 2; ++bj)
#pragma unroll
                        for (int n = 0; n < 2; ++n) {
                            const int col = col0 + bj * HALF + n * 16;
                            f32x4 bs;
                            if (xp) bs = *(const f32x4*)(bp + col);
                            else { const u32x2 hw = *(const u32x2*)(hb + (size_t)row * DM + col); bs = (f32x4){bflo(hw.x), bfhi(hw.x), bflo(hw.y), bfhi(hw.y)}; }
                            *(f32x4*)(Z + (size_t)row * DM + col) = bs * ALPHA + acc[ai][bj][m][n];
                        }
                }
            }
    }
};
struct EpiUp {
    static constexpr bool PERM = true, AFTER_DRAIN = false;
    bf16_t* U;
    __device__ __forceinline__ void operator()(const f32x4 (&acc)[2][2][4][2], const Unit& u, int wr, int wc, int fr, int fq) const {
        const int row0 = u.pm * BM + wr * 64 + fr, col0 = u.pn * BM + wc * 32 + 8 * fq;
#pragma unroll
        for (int ai = 0; ai < 2; ++ai)
#pragma unroll
            for (int m = 0; m < 4; ++m) {
                bf16_t* rowp = U + (size_t)(row0 + ai * HALF + m * 16) * DFF + col0;
#pragma unroll
                for (int bj = 0; bj < 2; ++bj) {
                    f32x4 v0 = acc[ai][bj][m][0], v1 = acc[ai][bj][m][1];
#pragma unroll
                    for (int i = 0; i < 4; ++i) { const float a = fmaxf(v0[i], 0.f), b = fmaxf(v1[i], 0.f); v0[i] = a * a; v1[i] = b * b; }
                    u32x4 w; w.x = pk2(v0[0], v0[1]); w.y = pk2(v0[2], v0[3]); w.z = pk2(v1[0], v1[1]); w.w = pk2(v1[2], v1[3]);
                    *(u32x4*)(rowp + bj * HALF) = w;
                }
            }
    }
};

struct TailOrder {
    int nN, KS, nslot, G, c, pm; long ksA, ksB, DA, DB;
    __device__ bool next(int i, Unit& u) const {
        const int L = i * G + c; if (L >= nN * nslot) return false;
        u.pm = pm; u.pn = L / nslot; u.slot = L % nslot; const int which = u.slot / KS, kk = u.slot % KS;
        u.offA = which * DA + kk * ksA; u.offB = which * DB + kk * ksB; return true;
    }
    __device__ __forceinline__ void a_ready(const Unit&) const {}
    __device__ __forceinline__ void done(const Unit&) const {}
};
struct TailArgs { float* part; unsigned* cnt; int N, nslot; PG8_LAS unsigned* flag; bf16_t* P; const float* base; float* Z; const bf16_t* hb; };
template <int KIND, int KS>
__device__ __forceinline__ void tail_finalize(const TailArgs& a, int pn) {
    const int t = threadIdx.x, cg = t & 15;
    const int col0 = pn * BM + cg * 16;
#pragma unroll 1
    for (int i = 0; i < 4; ++i) {
        const int row = (t >> 4) + 32 * i;
        const float* src = a.part + (size_t)row * a.N + col0;
        float x[16], y[16];
#pragma unroll
        for (int q = 0; q < 4; ++q) { f32x4 sa = (f32x4){0.f, 0.f, 0.f, 0.f}, sb = sa;
#pragma unroll
            for (int sl = 0; sl < KS; ++sl) sa += *(const f32x4*)(src + (size_t)sl * 128 * a.N + 4 * q);
            if (KIND == 1) {
#pragma unroll
                for (int sl = KS; sl < 2 * KS; ++sl) sb += *(const f32x4*)(src + (size_t)sl * 128 * a.N + 4 * q); }
#pragma unroll
            for (int j = 0; j < 4; ++j) { x[4 * q + j] = sa[j]; y[4 * q + j] = sb[j]; } }
        const size_t grow = (size_t)(MP + row);
        if (KIND == 0) {
            if (pn < 5 && (col0 & 63) == 0) {
                const float INV[8] = {1.0f, 0.1939227432012558f, 0.03760603070259094f, 0.007292664609849453f, 0.0014142135623842478f, 0.00027424818836152554f, 5.318296098266728e-05f, 1.0313386155758053e-05f};
#pragma unroll
                for (int k = 0; k < 8; ++k) { const float ang = (float)PAST_LEN * INV[k]; double rev = (double)ang * 0.15915494309189535; rev -= __builtin_rint(rev); const float rf = (float)rev;
                    const float cs = __builtin_amdgcn_cosf(rf), sn = __builtin_amdgcn_sinf(rf); const float x1 = x[k], x2 = x[k + 8]; x[k] = x1 * cs - x2 * sn; x[k + 8] = x2 * cs + x1 * sn; }
            }
            const float qs = (pn < 4) ? 0.125f : 1.0f;
            if (col0 >= COL_GA) {
#pragma unroll
                for (int k = 0; k < 16; ++k) x[k] = sigmoidf_(x[k]); }
            u32x4 w0, w1; w0.x = pk2(x[0] * qs, x[1] * qs); w0.y = pk2(x[2] * qs, x[3] * qs); w0.z = pk2(x[4] * qs, x[5] * qs); w0.w = pk2(x[6] * qs, x[7] * qs);
            w1.x = pk2(x[8] * qs, x[9] * qs); w1.y = pk2(x[10] * qs, x[11] * qs); w1.z = pk2(x[12] * qs, x[13] * qs); w1.w = pk2(x[14] * qs, x[15] * qs);
            *(u32x4*)(a.P + grow * LDP + col0) = w0; *(u32x4*)(a.P + grow * LDP + col0 + 8) = w1;
        } else if (KIND == 1) {
            const u32x4 ga0 = *(const u32x4*)(a.P + grow * LDP + COL_GA + col0), ga1 = *(const u32x4*)(a.P + grow * LDP + COL_GA + col0 + 8);
            const u32x4 gb0 = *(const u32x4*)(a.P + grow * LDP + COL_GB + col0), gb1 = *(const u32x4*)(a.P + grow * LDP + COL_GB + col0 + 8);
            float ga[16], gb[16];
            { float u8[8]; u8[0] = bflo(ga0.x); u8[1] = bfhi(ga0.x); u8[2] = bflo(ga0.y); u8[3] = bfhi(ga0.y); u8[4] = bflo(ga0.z); u8[5] = bfhi(ga0.z); u8[6] = bflo(ga0.w); u8[7] = bfhi(ga0.w);
#pragma unroll
              for (int k = 0; k < 8; ++k) ga[k] = u8[k];
              u8[0] = bflo(ga1.x); u8[1] = bfhi(ga1.x); u8[2] = bflo(ga1.y); u8[3] = bfhi(ga1.y); u8[4] = bflo(ga1.z); u8[5] = bfhi(ga1.z); u8[6] = bflo(ga1.w); u8[7] = bfhi(ga1.w);
#pragma unroll
              for (int k = 0; k < 8; ++k) ga[8 + k] = u8[k];
              u8[0] = bflo(gb0.x); u8[1] = bfhi(gb0.x); u8[2] = bflo(gb0.y); u8[3] = bfhi(gb0.y); u8[4] = bflo(gb0.z); u8[5] = bfhi(gb0.z); u8[6] = bflo(gb0.w); u8[7] = bfhi(gb0.w);
#pragma unroll
              for (int k = 0; k < 8; ++k) gb[k] = u8[k];
              u8[0] = bflo(gb1.x); u8[1] = bfhi(gb1.x); u8[2] = bflo(gb1.y); u8[3] = bfhi(gb1.y); u8[4] = bflo(gb1.z); u8[5] = bfhi(gb1.z); u8[6] = bflo(gb1.w); u8[7] = bfhi(gb1.w);
#pragma unroll
              for (int k = 0; k < 8; ++k) gb[8 + k] = u8[k]; }
            float o[16];
#pragma unroll
            for (int k = 0; k < 16; ++k) o[k] = x[k] * ga[k] + y[k] * gb[k];
            u32x4 w0, w1; w0.x = pk2(o[0], o[1]); w0.y = pk2(o[2], o[3]); w0.z = pk2(o[4], o[5]); w0.w = pk2(o[6], o[7]);
            w1.x = pk2(o[8], o[9]); w1.y = pk2(o[10], o[11]); w1.z = pk2(o[12], o[13]); w1.w = pk2(o[14], o[15]);
            *(u32x4*)(a.P + grow * LDP + COL_GA + col0) = w0; *(u32x4*)(a.P + grow * LDP + COL_GA + col0 + 8) = w1;
        } else if (KIND == 2) {
            const float* bp = a.base ? a.base + (size_t)row * DM + col0 : a.Z + grow * DM + col0;
#pragma unroll
            for (int q = 0; q < 4; ++q) { f32x4 bs;
                if (a.base) bs = *(const f32x4*)(bp + 4 * q);
                else { const u32x2 hw = *(const u32x2*)(a.hb + grow * DM + col0 + 4 * q); bs = (f32x4){bflo(hw.x), bfhi(hw.x), bflo(hw.y), bfhi(hw.y)}; }
                *(f32x4*)(a.Z + grow * DM + col0 + 4 * q) = (f32x4){bs[0] * ALPHA + x[4 * q], bs[1] * ALPHA + x[4 * q + 1], bs[2] * ALPHA + x[4 * q + 2], bs[3] * ALPHA + x[4 * q + 3]}; }
        } else {
#pragma unroll
            for (int k = 0; k < 16; ++k) { const float r = fmaxf(x[k], 0.f); x[k] = r * r; }
            u32x4 w0, w1; w0.x = pk2(x[0], x[1]); w0.y = pk2(x[2], x[3]); w0.z = pk2(x[4], x[5]); w0.w = pk2(x[6], x[7]);
            w1.x = pk2(x[8], x[9]); w1.y = pk2(x[10], x[11]); w1.z = pk2(x[12], x[13]); w1.w = pk2(x[14], x[15]);
            *(u32x4*)(a.P + grow * DFF + col0) = w0; *(u32x4*)(a.P + grow * DFF + col0 + 8) = w1;
        }
    }
}
template <bool PERM_, int KIND, int KS> struct EpiTail {
    static constexpr bool PERM = PERM_, AFTER_DRAIN = false;
    TailArgs a;
    __device__ __forceinline__ void operator()(const f32x4 (&acc)[2][2][4][2], const Unit& u, int wr, int wc, int fr, int fq) const {
        const int cbase = u.pn * BM + wc * 32 + (PERM ? 8 * fq : 4 * fq);
#pragma unroll
        for (int m = 0; m < 4; ++m)
#pragma unroll
            for (int bj = 0; bj < 2; ++bj)
#pragma unroll
                for (int n = 0; n < 2; ++n)
                    *(f32x4*)(a.part + ((size_t)u.slot * 128 + wr * 64 + m * 16 + fr) * a.N + cbase + bj * HALF + (PERM ? 4 * n : 16 * n)) = acc[0][bj][m][n];
        __builtin_amdgcn_fence(__ATOMIC_RELEASE, "agent");
        asm volatile("s_waitcnt vmcnt(0) lgkmcnt(0)" ::: "memory");
        __builtin_amdgcn_s_barrier();
        if (threadIdx.x == 0) { const unsigned old = __hip_atomic_fetch_add(a.cnt + u.pn, 1u, __ATOMIC_RELAXED, __HIP_MEMORY_SCOPE_AGENT); a.flag[0] = (old == (unsigned)(a.nslot - 1)) ? 1u : 0u; }
        asm volatile("s_waitcnt vmcnt(0) lgkmcnt(0)" ::: "memory");
        __builtin_amdgcn_s_barrier();
        asm volatile("" ::: "memory");
        const bool last = a.flag[0] != 0u;
        if (last) {
            __builtin_amdgcn_fence(__ATOMIC_ACQUIRE, "agent");
            asm volatile("s_waitcnt vmcnt(0)" ::: "memory");
            tail_finalize<KIND, KS>(a, u.pn);
        }
    }
};
}

__device__ __forceinline__ void p0_transpose_item(const float* W, int K, int N, bf16_t* WT, float* scr, int item, int lane) {
    const int nblk = N / 32, kb = item / nblk, nb = item % nblk, k0 = 64 * kb, n0 = 32 * nb;
#pragma unroll 8
    for (int i = 0; i < 32; ++i) { const int kk = 2 * i + (lane >> 5); scr[kk * 33 + (lane & 31)] = W[(size_t)(k0 + kk) * N + n0 + (lane & 31)]; }
    asm volatile("s_waitcnt lgkmcnt(0)" ::: "memory");
    const int c = lane & 7;
#pragma unroll
    for (int j = 0; j < 4; ++j) { const int n = (lane >> 3) + 8 * j; const float* s = scr + (8 * c) * 33 + n;
        u32x4 o; o.x = pk2(s[0 * 33], s[1 * 33]); o.y = pk2(s[2 * 33], s[3 * 33]); o.z = pk2(s[4 * 33], s[5 * 33]); o.w = pk2(s[6 * 33], s[7 * 33]);
        *(u32x4*)(WT + (size_t)(n0 + n) * K + k0 + 8 * c) = o; }
    asm volatile("s_waitcnt lgkmcnt(0)" ::: "memory");
}

__device__ __forceinline__ void phase0(const Params& p, unsigned char* lds) {
    const int tid = otid(), lane = tid & 63, wv = tid >> 6;
    const int G = gridDim.x, gw = blockIdx.x * 8 + wv, NGW = G * 8;
    const long gt = (long)blockIdx.x * NTHREADS + tid, NGT = (long)G * NTHREADS;
    unsigned char* ws = p.ws;
    float* scr = (float*)(lds + wv * 16384);
    constexpr int I_IN = 32 * 281, I_PA = 16 * 64, I_OUT = 32 * 64, I_UP = 32 * 256, I_DN = 128 * 64;
    constexpr int NIT = I_IN + 2 * I_PA + I_OUT + I_UP + I_DN;
    for (int it = gw; it < NIT; it += NGW) {
        int r = it;
        if (r < I_IN) { p0_transpose_item(p.in[6], DM, INW, (bf16_t*)(ws + WS_WIN), scr, r, lane); continue; } r -= I_IN;
        if (r < I_PA) { p0_transpose_item(p.in[19], AW, DM, (bf16_t*)(ws + WS_WPA), scr, r, lane); continue; } r -= I_PA;
        if (r < I_PA) { p0_transpose_item(p.in[20], AW, DM, (bf16_t*)(ws + WS_WPR), scr, r, lane); continue; } r -= I_PA;
        if (r < I_OUT) { p0_transpose_item(p.in[21], DM, DM, (bf16_t*)(ws + WS_WOUT), scr, r, lane); continue; } r -= I_OUT;
        if (r < I_UP) { p0_transpose_item(p.in[24], DM, DFF, (bf16_t*)(ws + WS_WUP), scr, r, lane); continue; } r -= I_UP;
        p0_transpose_item(p.in[25], DFF, DM, (bf16_t*)(ws + WS_WDN), scr, r, lane);
    }
    { u32x4* z = (u32x4*)(ws + WS_WIN + (size_t)INW * DM * 2); const long n16 = (long)(LDP - INW) * DM * 2 / 16;
      for (long e = gt; e < n16; e += NGT) z[e] = (u32x4){0u, 0u, 0u, 0u}; }
    { bf16_t* WdT = (bf16_t*)(ws + WS_LORA); bf16_t* WaT = WdT + 1024 * 64; bf16_t* WgT = WaT + 1024 * 64;
      const float* Wd = p.in[10]; const float* Wa = p.in[12]; const float* Wg = p.in[13];
      for (long e = gt; e < 1024 * 64; e += NGT) { const int n = (int)(e >> 6), k = (int)(e & 63); WdT[e] = (bf16_t)(pk2(Wd[k * 1024 + n], 0.f) & 0xffffu); WaT[e] = (bf16_t)(pk2(Wa[k * 1024 + n], 0.f) & 0xffffu); }
      for (long e = gt; e < 1024 * 160; e += NGT) { const int n = (int)(e / 160), k = (int)(e % 160); WgT[e] = (bf16_t)(pk2(Wg[k * 1024 + n], 0.f) & 0xffffu); } }
    { bf16_t* Xb = (bf16_t*)(ws + WS_A); const float* xp = p.in[0]; const float* xs = p.in[1];
      for (long e = gt; e < (long)MPAD * 256; e += NGT) { const int row = (int)(e >> 8), c8 = (int)(e & 255) * 8;
          u32x4 o = (u32x4){0u, 0u, 0u, 0u};
          if (row < MREAL) { const float* src = (row < MP) ? xp + (size_t)row * DM + c8 : xs + (size_t)(row - MP) * DM + c8;
              const f32x4 a = *(const f32x4*)src, b = *(const f32x4*)(src + 4);
              o.x = pk2(a[0], a[1]); o.y = pk2(a[2], a[3]); o.z = pk2(b[0], b[1]); o.w = pk2(b[2], b[3]); }
          *(u32x4*)(Xb + (size_t)row * DM + c8) = o; } }
}

__device__ __forceinline__ void attn_prompt_unit(unsigned char* lds, const bf16_t* P, bf16_t* attn_o, const float* sinks, int unit) {
    const int qblk = unit & 63, kvh = (unit >> 6) & 3, b = unit >> 8;
    const int tid = otid(), lane = tid & 63, wid = tid >> 6, fr = lane & 15, fq = lane >> 4;
    bf16_t* Ks = (bf16_t*)lds;
    bf16_t* Vt = (bf16_t*)(lds + 256 * 144);
    const long row0 = (long)b * SEQ + (long)(qblk - 1) * 128;
    const long tokrow = (long)b * SEQ + (long)qblk * 128 + 16 * wid + fr;
    bf16x8 qf[4][2];
#pragma unroll
    for (int g = 0; g < 4; ++g) { const bf16_t* qp = P + (size_t)tokrow * LDP + COL_Q + (kvh * 4 + g) * 64 + fq * 8; qf[g][0] = *(const bf16x8*)(qp); qf[g][1] = *(const bf16x8*)(qp + 32); }
#pragma unroll
    for (int i = 0; i < 4; ++i) {
        const int ch = tid + i * NTHREADS; const int key = ch >> 3, c8 = ch & 7;
        u32x4 kv = (u32x4){0u, 0u, 0u, 0u}, vv = (u32x4){0u, 0u, 0u, 0u};
        if (qblk > 0 || key >= 128) {
            const bf16_t* src = P + (size_t)(row0 + key) * LDP + kvh * 64 + c8 * 8;
            kv = *(const u32x4*)(src + COL_K); vv = *(const u32x4*)(src + COL_V);
        }
        *(u32x4*)(Ks + key * 72 + c8 * 8) = kv;
        bf16_t* vd = Vt + (c8 * 8) * 264 + key;
        vd[0 * 264] = (bf16_t)(vv.x & 0xffffu); vd[1 * 264] = (bf16_t)(vv.x >> 16);
        vd[2 * 264] = (bf16_t)(vv.y & 0xffffu); vd[3 * 264] = (bf16_t)(vv.y >> 16);
        vd[4 * 264] = (bf16_t)(vv.z & 0xffffu); vd[5 * 264] = (bf16_t)(vv.z >> 16);
        vd[6 * 264] = (bf16_t)(vv.w & 0xffffu); vd[7 * 264] = (bf16_t)(vv.w >> 16);
    }
    __syncthreads();
    const int qrel = 128 + 16 * wid + fr;
    const int kb0 = wid & ~1;
    const float L2E = 1.4426950408889634f;
#pragma unroll
    for (int g = 0; g < 4; ++g) {
        const int head = kvh * 4 + g;
        const bf16x8 qf0 = qf[g][0], qf1 = qf[g][1];
        f32x4 s[10];
#pragma unroll
        for (int jb = 0; jb < 10; ++jb) {
            const bf16_t* kp = Ks + (16 * (kb0 + jb) + fr) * 72 + fq * 8;
            const bf16x8 k0 = *(const bf16x8*)(kp), k1 = *(const bf16x8*)(kp + 32);
            f32x4 a = (f32x4){0.f, 0.f, 0.f, 0.f};
            a = __builtin_amdgcn_mfma_f32_16x16x32_bf16(k0, qf0, a, 0, 0, 0);
            a = __builtin_amdgcn_mfma_f32_16x16x32_bf16(k1, qf1, a, 0, 0, 0);
            s[jb] = a;
        }
        const float sink = sinks[head];
        float mx = sink;
#pragma unroll
        for (int jb = 0; jb < 10; ++jb)
#pragma unroll
            for (int j = 0; j < 4; ++j) {
                const int kidx = 16 * (kb0 + jb) + 4 * fq + j;
                const bool ok = (kidx <= qrel) && (kidx > qrel - 128) && (qblk > 0 || kidx >= 128);
                const float v = ok ? s[jb][j] : -INFINITY;
                s[jb][j] = v; mx = fmaxf(mx, v);
            }
        mx = fmaxf(mx, __shfl_xor(mx, 16)); mx = fmaxf(mx, __shfl_xor(mx, 32));
        float l = 0.f;
#pragma unroll
        for (int jb = 0; jb < 10; ++jb)
#pragma unroll
            for (int j = 0; j < 4; ++j) { const float e = __builtin_amdgcn_exp2f((s[jb][j] - mx) * L2E); s[jb][j] = e; l += e; }
        l += __shfl_xor(l, 16); l += __shfl_xor(l, 32);
        l += __builtin_amdgcn_exp2f((sink - mx) * L2E);
        const float rl = 1.0f / l;
        f32x4 o[4];
#pragma unroll
        for (int db = 0; db < 4; ++db) o[db] = (f32x4){0.f, 0.f, 0.f, 0.f};
#pragma unroll
        for (int G2 = 0; G2 < 5; ++G2) {
            u32x4 pw; pw.x = pk2s(s[2 * G2][0], s[2 * G2][1]); pw.y = pk2s(s[2 * G2][2], s[2 * G2][3]); pw.z = pk2s(s[2 * G2 + 1][0], s[2 * G2 + 1][1]); pw.w = pk2s(s[2 * G2 + 1][2], s[2 * G2 + 1][3]);
            const bf16x8 pb = __builtin_bit_cast(bf16x8, pw);
#pragma unroll
            for (int db = 0; db < 4; ++db) {
                const bf16_t* vp = Vt + (16 * db + fr) * 264 + 16 * (kb0 + 2 * G2) + 4 * fq;
                const u32x2 v0 = *(const u32x2*)(vp), v1 = *(const u32x2*)(vp + 16);
                u32x4 vw; vw.x = v0.x; vw.y = v0.y; vw.z = v1.x; vw.w = v1.y;
                o[db] = __builtin_amdgcn_mfma_f32_16x16x32_bf16(__builtin_bit_cast(bf16x8, vw), pb, o[db], 0, 0, 0);
            }
        }
        bf16_t* op = attn_o + (size_t)tokrow * AW + head * 64 + 4 * fq;
#pragma unroll
        for (int db = 0; db < 4; ++db) { u32x2 w; w.x = pk2(o[db][0] * rl, o[db][1] * rl); w.y = pk2(o[db][2] * rl, o[db][3] * rl); *(u32x2*)(op + 16 * db) = w; }
    }
    __syncthreads();
}

__device__ __forceinline__ void attn_sample_unit(const Params& p, const bf16_t* P, bf16_t* attn_o, unsigned char* lds, int unit) {
    const int b = unit >> 2, kvh = unit & 3, tid = otid();
    float* Kc = (float*)lds;
    float* Vc = Kc + 128 * 68;
    float* Kn = Vc + 128 * 64;
    float* Vn = Kn + 64;
    float* qs = Vn + 64;
    float* sc = qs + 256;
    const float* ck = p.in[2] + ((size_t)b * 128 * 4 + kvh) * 64;
    const float* cv = p.in[3] + ((size_t)b * 128 * 4 + kvh) * 64;
    float* ok = p.out + O_KWS + ((size_t)b * 128 * 4 + kvh) * 64;
    float* ov = p.out + O_VWS + ((size_t)b * 128 * 4 + kvh) * 64;
    const bf16_t* prow = P + (size_t)(MP + b) * LDP;
    f32x4 kr[4], vr[4];
#pragma unroll
    for (int i = 0; i < 4; ++i) { const int idx = tid + i * NTHREADS, key = idx >> 4, c4 = (idx & 15) * 4;
        kr[i] = *(const f32x4*)(ck + (size_t)key * 256 + c4); vr[i] = *(const f32x4*)(cv + (size_t)key * 256 + c4); }
#pragma unroll
    for (int i = 0; i < 4; ++i) { const int idx = tid + i * NTHREADS, key = idx >> 4, c4 = (idx & 15) * 4;
        *(f32x4*)(Kc + key * 68 + c4) = kr[i]; *(f32x4*)(Vc + key * 64 + c4) = vr[i];
        if (key >= 1) { *(f32x4*)(ok + (size_t)(key - 1) * 256 + c4) = kr[i]; *(f32x4*)(ov + (size_t)(key - 1) * 256 + c4) = vr[i]; } }
    if (tid < 64) { const float kn = bf2f(prow[COL_K + kvh * 64 + tid]), vn = bf2f(prow[COL_V + kvh * 64 + tid]);
        Kn[tid] = kn; Vn[tid] = vn; ok[(size_t)127 * 256 + tid] = kn; ov[(size_t)127 * 256 + tid] = vn; }
    else if (tid < 320) { const int e = tid - 64; qs[e] = bf2f(prow[COL_Q + kvh * 256 + e]); }
    __syncthreads();
    { const int h = tid >> 7, key = tid & 127;
      const float* qh = qs + h * 64; const float* kp = (key == 0) ? Kn : Kc + key * 68;
      float s0 = 0.f, s1 = 0.f;
#pragma unroll
      for (int d = 0; d < 64; d += 8) { const f32x4 ka = *(const f32x4*)(kp + d), kb = *(const f32x4*)(kp + d + 4), qa = *(const f32x4*)(qh + d), qb = *(const f32x4*)(qh + d + 4);
          s0 += ka[0] * qa[0] + ka[1] * qa[1] + ka[2] * qa[2] + ka[3] * qa[3]; s1 += kb[0] * qb[0] + kb[1] * qb[1] + kb[2] * qb[2] + kb[3] * qb[3]; }
      sc[h * 132 + ((key == 0) ? 128 : key)] = s0 + s1; }
    __syncthreads();
    if (tid < 256) { const int h = tid >> 6, d = tid & 63; const float* sh = sc + h * 132;
        const float sink = p.in[7][kvh * 4 + h];
        float m = sink;
        for (int k = 1; k <= 128; ++k) m = fmaxf(m, sh[k]);
        float l = __expf(sink - m), o = 0.f;
#pragma unroll 4
        for (int k = 1; k < 128; ++k) { const float e = __expf(sh[k] - m); l += e; o += e * Vc[k * 64 + d]; }
        { const float e = __expf(sh[128] - m); l += e; o += e * Vn[d]; }
        attn_o[(size_t)(MP + b) * AW + (kvh * 4 + h) * 64 + d] = (bf16_t)(pk2(o / l, 0.f) & 0xffffu); }
    __syncthreads();
}

__device__ __forceinline__ void lerp8(const bf16_t* prow, const float* sprev, const float* mu, bool is_s, bool first, int col, float (&x)[8]) {
    const u32x4 c = *(const u32x4*)(prow + col);
    const float cur[8] = {bflo(c.x), bfhi(c.x), bflo(c.y), bfhi(c.y), bflo(c.z), bfhi(c.z), bflo(c.w), bfhi(c.w)};
    float pv[8];
    if (is_s) { const f32x4 a = *(const f32x4*)(sprev + col - COL_R), bq = *(const f32x4*)(sprev + col - COL_R + 4);
        pv[0] = a[0]; pv[1] = a[1]; pv[2] = a[2]; pv[3] = a[3]; pv[4] = bq[0]; pv[5] = bq[1]; pv[6] = bq[2]; pv[7] = bq[3]; }
    else if (first) {
#pragma unroll
        for (int i = 0; i < 8; ++i) pv[i] = 0.f; }
    else { const u32x4 q = *(const u32x4*)(prow - LDP + col);
        pv[0] = bflo(q.x); pv[1] = bfhi(q.x); pv[2] = bflo(q.y); pv[3] = bfhi(q.y); pv[4] = bflo(q.z); pv[5] = bfhi(q.z); pv[6] = bflo(q.w); pv[7] = bfhi(q.w); }
    const f32x4 m0 = *(const f32x4*)(mu + col - COL_R), m1 = *(const f32x4*)(mu + col - COL_R + 4);
    const float mm[8] = {m0[0], m0[1], m0[2], m0[3], m1[0], m1[1], m1[2], m1[3]};
#pragma unroll
    for (int i = 0; i < 8; ++i) x[i] = cur[i] + (pv[i] - cur[i]) * mm[i];
}

__device__ __forceinline__ void lora_wave_unit(const Params& p, const bf16_t* P, int wu, int nb0, int nbn, int lane) {
    const int fr = lane & 15, fq = lane >> 4;
    const int row = wu * 16 + fr;
    const bool is_s = row >= MP; const bool first = (row & (SEQ - 1)) == 0;
    const bf16_t* prow = P + (size_t)row * LDP;
    const float* sprev = p.in[4] + (size_t)(is_s ? row - MP : 0) * RW;
    const float* mu = p.in[8];
    bf16x8 actw[2], acta[2], actg[5];
#pragma unroll
    for (int kk = 0; kk < 2; ++kk) {
        float x[8]; lerp8(prow, sprev, mu, is_s, first, COL_WD + 32 * kk + 8 * fq, x);
#pragma unroll
        for (int i = 0; i < 8; ++i) { const float e = __expf(2.f * x[i]); x[i] = 1.f - 2.f / (e + 1.f); }
        u32x4 w; w.x = pk2(x[0], x[1]); w.y = pk2(x[2], x[3]); w.z = pk2(x[4], x[5]); w.w = pk2(x[6], x[7]); actw[kk] = __builtin_bit_cast(bf16x8, w);
        lerp8(prow, sprev, mu, is_s, first, COL_AD + 32 * kk + 8 * fq, x);
        w.x = pk2(x[0], x[1]); w.y = pk2(x[2], x[3]); w.z = pk2(x[4], x[5]); w.w = pk2(x[6], x[7]); acta[kk] = __builtin_bit_cast(bf16x8, w);
    }
#pragma unroll
    for (int kk = 0; kk < 5; ++kk) {
        float x[8]; lerp8(prow, sprev, mu, is_s, first, COL_GD + 32 * kk + 8 * fq, x);
#pragma unroll
        for (int i = 0; i < 8; ++i) x[i] = sigmoidf_(x[i]);
        u32x4 w; w.x = pk2s(x[0], x[1]); w.y = pk2s(x[2], x[3]); w.z = pk2s(x[4], x[5]); w.w = pk2s(x[6], x[7]); actg[kk] = __builtin_bit_cast(bf16x8, w);
    }
    const bf16_t* WdT = (const bf16_t*)(p.ws + WS_LORA); const bf16_t* WaT = WdT + 1024 * 64; const bf16_t* WgT = WaT + 1024 * 64;
    const float* w0 = p.in[9]; const float* a0 = p.in[11];
    unsigned char* lw = (unsigned char*)p.out + (size_t)row * 8192;
#define LORA_LOAD(WD, WA, WG, W0V, A0V, NB) do { const int c_ = (NB) * 16 + fr; \
        _Pragma("unroll") for (int kk = 0; kk < 2; ++kk) { WD[kk] = *(const bf16x8*)(WdT + c_ * 64 + kk * 32 + fq * 8); WA[kk] = *(const bf16x8*)(WaT + c_ * 64 + kk * 32 + fq * 8); } \
        _Pragma("unroll") for (int kk = 0; kk < 5; ++kk) WG[kk] = *(const bf16x8*)(WgT + c_ * 160 + kk * 32 + fq * 8); \
        W0V = *(const f32x4*)(w0 + (NB) * 16 + 4 * fq); A0V = *(const f32x4*)(a0 + (NB) * 16 + 4 * fq); } while (0)
#define LORA_COMPUTE(WD, WA, WG, W0V, A0V, NB) do { \
        f32x4 accw = (f32x4){0.f, 0.f, 0.f, 0.f}, acca = accw, accg = accw; \
        _Pragma("unroll") for (int kk = 0; kk < 2; ++kk) { \
            accw = __builtin_amdgcn_mfma_f32_16x16x32_bf16(WD[kk], actw[kk], accw, 0, 0, 0); \
            acca = __builtin_amdgcn_mfma_f32_16x16x32_bf16(WA[kk], acta[kk], acca, 0, 0, 0); } \
        _Pragma("unroll") for (int kk = 0; kk < 5; ++kk) accg = __builtin_amdgcn_mfma_f32_16x16x32_bf16(WG[kk], actg[kk], accg, 0, 0, 0); \
        const int cc = (NB) * 16 + 4 * fq; \
        f32x4 dec; float av[4]; \
        _Pragma("unroll") for (int j = 0; j < 4; ++j) { \
            const float xx = -(W0V[j] + accw[j]); \
            const float sp = fmaxf(xx, 0.f) + __logf(1.f + __expf(-fabsf(xx))); \
            dec[j] = __expf(-__expf(-sp - 0.5f)); \
            av[j] = sigmoidf_(A0V[j] + acca[j]); } \
        *(f32x4*)(lw + (size_t)cc * 4) = dec; \
        u32x2 aw; aw.x = pk2s(av[0], av[1]); aw.y = pk2s(av[2], av[3]);     *(u32x2*)(lw + 4096 + (size_t)cc * 2) = aw; \
        u32x2 gw; gw.x = pk2s(accg[0], accg[1]); gw.y = pk2s(accg[2], accg[3]); *(u32x2*)(lw + 6144 + (size_t)cc * 2) = gw; } while (0)
    bf16x8 wdA[2], waA[2], wgA[5], wdB[2], waB[2], wgB[5]; f32x4 w0A, a0A, w0B, a0B;
    LORA_LOAD(wdA, waA, wgA, w0A, a0A, nb0);
#pragma unroll 1
    for (int nb = nb0; nb < nb0 + nbn; nb += 2) {
        LORA_LOAD(wdB, waB, wgB, w0B, a0B, nb + 1);
        LORA_COMPUTE(wdA, waA, wgA, w0A, a0A, nb);
        { const int nn = (nb + 2 < nb0 + nbn) ? nb + 2 : nb; LORA_LOAD(wdA, waA, wgA, w0A, a0A, nn); }
        LORA_COMPUTE(wdB, waB, wgB, w0B, a0B, nb + 1);
    }
#undef LORA_LOAD
#undef LORA_COMPUTE
}

__device__ __forceinline__ void phase2(const Params& p, unsigned char* lds) {
    const int tid = otid(), lane = tid & 63, wv = tid >> 6;
    const int G = gridDim.x;
    const bf16_t* P = (const bf16_t*)(p.ws + WS_P);
    bf16_t* attn_o = (bf16_t*)(p.ws + WS_A);
    REP(10) { for (int task = blockIdx.x; task < 256; task += G) { const int wt = task * 8 + wv; lora_wave_unit(p, P, wt >> 1, (wt & 1) * 32, 32, lane); }
      if (wv == 0) for (int m = blockIdx.x; m < 256; m += G) { const int wt = 2048 + (m >> 4); lora_wave_unit(p, P, wt >> 1, (wt & 1) * 32 + (m & 15) * 2, 2, lane); } }
    REP(12) for (int task = blockIdx.x + 254 - ((blockIdx.x + 254) / G) * G; task < 512; task += G) attn_sample_unit(p, P, attn_o, lds, task);
    REP(11) for (int task = blockIdx.x; task < 512; task += G) attn_prompt_unit(lds, P, attn_o, p.in[7], task);
    const long gt = (long)blockIdx.x * NTHREADS + tid, NGT = (long)G * NTHREADS;
    for (long e = gt; e < 2 * 65536; e += NGT) {
        const int which = (int)(e >> 16), r = (int)(e & 65535), bb = r >> 15, s = (r >> 8) & 127, c = r & 255;
        const bf16_t* src = P + (size_t)(bb * SEQ + SEQ - 128 + s) * LDP + (which ? COL_V : COL_K) + c;
        p.out[(which ? O_VWP : O_KWP) + r] = bf2f(*src);
    }
    for (long e = gt; e < (long)(NBATCH + MS) * RW; e += NGT) {
        const int sq = (int)(e / RW), c = (int)(e % RW);
        const int row = (sq < NBATCH) ? sq * SEQ + SEQ - 1 : MP + (sq - NBATCH);
        const float v = bf2f(P[(size_t)row * LDP + COL_R + c]);
        if (sq < NBATCH) p.out[O_SHP + (size_t)sq * RW + c] = v; else p.out[O_SHS + (size_t)(sq - NBATCH) * RW + c] = v;
    }
}

struct PrepRegs { u32x4 cr, ck, cv, pr, pk, pv, a; f32x4 w0, w1; };
__device__ __forceinline__ void unpack8(const u32x4 c, float (&x)[8]) { x[0] = bflo(c.x); x[1] = bfhi(c.x); x[2] = bflo(c.y); x[3] = bfhi(c.y); x[4] = bflo(c.z); x[5] = bfhi(c.z); x[6] = bflo(c.w); x[7] = bfhi(c.w); }

__device__ __forceinline__ void prep_issue(PrepRegs& R, const Params& p, const bf16_t* P, int row, int h, int cb) {
    const bf16_t* q = P + (size_t)row * LDP + h * 64 + cb * 8;
    const bf16_t* qp = (row > 0) ? q - LDP : q;
    R.cr = *(const u32x4*)(q + COL_R); R.ck = *(const u32x4*)(q + COL_RK); R.cv = *(const u32x4*)(q + COL_RV);
    R.pr = *(const u32x4*)(qp + COL_R); R.pk = *(const u32x4*)(qp + COL_RK); R.pv = *(const u32x4*)(qp + COL_RV);
    const unsigned char* lw = (const unsigned char*)p.out + (size_t)row * 8192;
    R.w0 = *(const f32x4*)(lw + (size_t)(h * 64 + cb * 8) * 4); R.w1 = *(const f32x4*)(lw + (size_t)(h * 64 + cb * 8) * 4 + 16);
    R.a = *(const u32x4*)(lw + 4096 + (size_t)(h * 64 + cb * 8) * 2);
}
template <int SUBN, bool WITH_R>
__device__ __forceinline__ void prep_finish(const PrepRegs& R, float* st, const float* cst, int tt, int cb, bool zero_prev, const float* sprev  , int h) {
    float cr[8], ck[8], cv[8], pr[8], pk[8], pv[8], a[8];
    unpack8(R.cr, cr); unpack8(R.ck, ck); unpack8(R.cv, cv); unpack8(R.a, a);
    if (sprev) {
        const float* s0 = sprev + h * 64 + cb * 8;
        const f32x4 r0 = *(const f32x4*)(s0), r1 = *(const f32x4*)(s0 + 4), k0 = *(const f32x4*)(s0 + 1024), k1 = *(const f32x4*)(s0 + 1028), v0 = *(const f32x4*)(s0 + 2048), v1 = *(const f32x4*)(s0 + 2052);
#pragma unroll
        for (int i = 0; i < 4; ++i) { pr[i] = r0[i]; pr[i + 4] = r1[i]; pk[i] = k0[i]; pk[i + 4] = k1[i]; pv[i] = v0[i]; pv[i + 4] = v1[i]; }
    } else { unpack8(R.pr, pr); unpack8(R.pk, pk); unpack8(R.pv, pv);
        if (zero_prev) {
#pragma unroll
            for (int i = 0; i < 8; ++i) { pr[i] = 0.f; pk[i] = 0.f; pv[i] = 0.f; } } }
    const float* c0 = cst + cb * 8;
    float mur[8], muk[8], muv[8], kkc[8], kac[8];
#pragma unroll
    for (int i = 0; i < 8; i += 4) {
        const f32x4 m0 = *(const f32x4*)(c0 + i), m1 = *(const f32x4*)(c0 + 64 + i), m2 = *(const f32x4*)(c0 + 128 + i), m3 = *(const f32x4*)(c0 + 192 + i), m4 = *(const f32x4*)(c0 + 256 + i);
#pragma unroll
        for (int j = 0; j < 4; ++j) { mur[i + j] = m0[j]; muk[i + j] = m1[j]; muv[i + j] = m2[j]; kkc[i + j] = m3[j]; kac[i + j] = m4[j]; }
    }
    const float w[8] = {R.w0[0], R.w0[1], R.w0[2], R.w0[3], R.w1[0], R.w1[1], R.w1[2], R.w1[3]};
    float rs[8], ks[8], vs[8], kr[8]; float ss = 0.f;
#pragma unroll
    for (int i = 0; i < 8; ++i) { rs[i] = cr[i] + (pr[i] - cr[i]) * mur[i]; ks[i] = ck[i] + (pk[i] - ck[i]) * muk[i]; vs[i] = cv[i] + (pv[i] - cv[i]) * muv[i]; kr[i] = ks[i] * kkc[i]; ss += kr[i] * kr[i]; }
    ss = red8(ss);
    const float rn = __builtin_amdgcn_rsqf(fmaxf(ss, 1e-24f));
    float na[8], bb[8], kp[8];
#pragma unroll
    for (int i = 0; i < 8; ++i) { const float kk = kr[i] * rn; na[i] = -kk; bb[i] = kk * a[i]; kp[i] = ks[i] * (1.f + (a[i] - 1.f) * kac[i]); }
    float* d = st + tt * 64 + cb * 8;
#define ST8(arr, x) do { *(f32x4*)(d + (arr) * SUBN * 64) = (f32x4){x[0], x[1], x[2], x[3]}; *(f32x4*)(d + (arr) * SUBN * 64 + 4) = (f32x4){x[4], x[5], x[6], x[7]}; } while (0)
    ST8(0, w); ST8(1, na); ST8(2, bb); ST8(3, kp); ST8(4, vs);
    if (WITH_R) ST8(5, rs);
#undef ST8
}
template <int SUBN, bool WITH_R>
__device__ __forceinline__ void prep_finish_norm(const PrepRegs& R, float* st, const float* cst, int tt, int cb, bool zero_prev, int h, int lane, int wq) {
    const float* sprev = nullptr;
    float cr[8], ck[8], cv[8], pr[8], pk[8], pv[8], a[8];
    unpack8(R.cr, cr); unpack8(R.ck, ck); unpack8(R.cv, cv); unpack8(R.a, a);
    if (sprev) {
        const float* s0 = sprev + h * 64 + cb * 8;
        const f32x4 r0 = *(const f32x4*)(s0), r1 = *(const f32x4*)(s0 + 4), k0 = *(const f32x4*)(s0 + 1024), k1 = *(const f32x4*)(s0 + 1028), v0 = *(const f32x4*)(s0 + 2048), v1 = *(const f32x4*)(s0 + 2052);
#pragma unroll
        for (int i = 0; i < 4; ++i) { pr[i] = r0[i]; pr[i + 4] = r1[i]; pk[i] = k0[i]; pk[i + 4] = k1[i]; pv[i] = v0[i]; pv[i + 4] = v1[i]; }
    } else { unpack8(R.pr, pr); unpack8(R.pk, pk); unpack8(R.pv, pv);
        if (zero_prev) {
#pragma unroll
            for (int i = 0; i < 8; ++i) { pr[i] = 0.f; pk[i] = 0.f; pv[i] = 0.f; } } }
    const float* c0 = cst + cb * 8;
    float mur[8], muk[8], muv[8], kkc[8], kac[8];
#pragma unroll
    for (int i = 0; i < 8; i += 4) {
        const f32x4 m0 = *(const f32x4*)(c0 + i), m1 = *(const f32x4*)(c0 + 64 + i), m2 = *(const f32x4*)(c0 + 128 + i), m3 = *(const f32x4*)(c0 + 192 + i), m4 = *(const f32x4*)(c0 + 256 + i);
#pragma unroll
        for (int j = 0; j < 4; ++j) { mur[i + j] = m0[j]; muk[i + j] = m1[j]; muv[i + j] = m2[j]; kkc[i + j] = m3[j]; kac[i + j] = m4[j]; }
    }
    const float w[8] = {R.w0[0], R.w0[1], R.w0[2], R.w0[3], R.w1[0], R.w1[1], R.w1[2], R.w1[3]};
    float rs[8], ks[8], vs[8], kr[8]; float ss = 0.f;
#pragma unroll
    for (int i = 0; i < 8; ++i) { rs[i] = cr[i] + (pr[i] - cr[i]) * mur[i]; ks[i] = ck[i] + (pk[i] - ck[i]) * muk[i]; vs[i] = cv[i] + (pv[i] - cv[i]) * muv[i]; kr[i] = ks[i] * kkc[i]; ss += kr[i] * kr[i]; }
    ss = red8(ss);
    const float rn = __builtin_amdgcn_rsqf(fmaxf(ss, 1e-24f));
    float na[8], bb[8], kp[8];
#pragma unroll
    for (int i = 0; i < 8; ++i) { const float kk = kr[i] * rn; na[i] = -kk; bb[i] = kk * a[i]; kp[i] = ks[i] * (1.f + (a[i] - 1.f) * kac[i]); }
    float g[8];
#pragma unroll
    for (int i = 0; i < 8; ++i) g[i] = w[i];
#pragma unroll
    for (int d8 = 8; d8 < 64; d8 <<= 1) {
#pragma unroll
        for (int i = 0; i < 8; ++i) { const float t = __shfl_up(g[i], d8); g[i] = (lane >= d8) ? g[i] * t : g[i]; }
    }
    float* tot = st;
    if ((lane >> 3) == 7) { *(f32x4*)(tot + wq * 64 + cb * 8) = (f32x4){g[0], g[1], g[2], g[3]}; *(f32x4*)(tot + wq * 64 + cb * 8 + 4) = (f32x4){g[4], g[5], g[6], g[7]}; }
    __syncthreads();
#pragma unroll
    for (int w_ = 0; w_ < 3; ++w_) {
        if (w_ < wq) { const f32x4 t0 = *(const f32x4*)(tot + w_ * 64 + cb * 8), t1 = *(const f32x4*)(tot + w_ * 64 + cb * 8 + 4);
#pragma unroll
            for (int i = 0; i < 4; ++i) { g[i] *= t0[i]; g[i + 4] *= t1[i]; } }
    }
    if (tt == SUBN - 1) { *(f32x4*)(tot + 256 + cb * 8) = (f32x4){g[0], g[1], g[2], g[3]}; *(f32x4*)(tot + 256 + cb * 8 + 4) = (f32x4){g[4], g[5], g[6], g[7]}; }
#pragma unroll
    for (int i = 0; i < 8; ++i) { const float inv = __builtin_amdgcn_rcpf(g[i]); const float gex = g[i] * __builtin_amdgcn_rcpf(w[i]); na[i] *= gex; bb[i] *= inv; kp[i] *= inv; rs[i] *= g[i]; }
    float* d = st + tt * 64 + cb * 8;
#define ST8(arr, x) do { *(f32x4*)(d + (arr) * SUBN * 64) = (f32x4){x[0], x[1], x[2], x[3]}; *(f32x4*)(d + (arr) * SUBN * 64 + 4) = (f32x4){x[4], x[5], x[6], x[7]}; } while (0)
    ST8(1, na); ST8(2, bb); ST8(3, kp); ST8(4, vs);
    if (WITH_R) ST8(5, rs);
#undef ST8
}

__device__ __forceinline__ void load_cst(const Params& p, float* cst, int h, int utid) {
    const int arr = utid >> 6, j = utid & 63;
    if (arr < 8) { const float* src = (arr < 3) ? p.in[8] + arr * 1024 : (arr == 3) ? p.in[14] : (arr == 4) ? p.in[15] : (arr == 5) ? p.in[16] : (arr == 6) ? p.in[17] : p.in[18];
        cst[arr * 64 + j] = src[h * 64 + j]; }
}

#define LD8S(dst, arr, SUBN) do { const f32x4 _a = *(const f32x4*)(st + ((arr) * SUBN + tt) * 64 + cb * 8), _b = *(const f32x4*)(st + ((arr) * SUBN + tt) * 64 + cb * 8 + 4); \
    dst[0] = (f32x2){_a[0], _a[1]}; dst[1] = (f32x2){_a[2], _a[3]}; dst[2] = (f32x2){_b[0], _b[1]}; dst[3] = (f32x2){_b[2], _b[3]}; } while (0)

constexpr int SUB1 = 64, SUB3 = 32;
__device__ __forceinline__ void scan_pass1_unit(const Params& p, const bf16_t* P, float* PU, float* ldsf, int unit) {
    const int bh = unit / (NCH - 1), ch = unit % (NCH - 1), b = bh >> 4, h = bh & 15;
    const int tid = otid();
    const int rp = tid >> 3, cb = tid & 7;
    float* st = ldsf; float* cst = ldsf + 5 * SUB1 * 64;
    f32x2 S0[4], S1[4];
#pragma unroll
    for (int c = 0; c < 4; ++c) {
        const int c0 = cb * 8 + 2 * c, i0 = 2 * rp - 64, i1 = 2 * rp - 63;
        S0[c] = (f32x2){(c0 == i0) ? 1.f : 0.f, (c0 + 1 == i0) ? 1.f : 0.f};
        S1[c] = (f32x2){(c0 == i1) ? 1.f : 0.f, (c0 + 1 == i1) ? 1.f : 0.f};
    }
    const bool urow = rp < 32;
    const int rowbase = b * SEQ + ch * CHUNK;
    load_cst(p, cst, h, tid);
    PrepRegs R; prep_issue(R, p, P, rowbase + rp, h, cb);
    __syncthreads();
    for (int sc = 0; sc < CHUNK / SUB1; ++sc) {
        prep_finish<SUB1, false>(R, st, cst, rp, cb, ((rowbase + sc * SUB1 + rp) & (SEQ - 1)) == 0, nullptr, h);
        __syncthreads();
        if (sc + 1 < CHUNK / SUB1) prep_issue(R, p, P, rowbase + (sc + 1) * SUB1 + rp, h, cb);
#pragma unroll 2
        for (int tt = 0; tt < SUB1; ++tt) {
            f32x2 w2[4], a2[4], b2[4], k2[4];
            LD8S(w2, 0, SUB1); LD8S(a2, 1, SUB1); LD8S(b2, 2, SUB1); LD8S(k2, 3, SUB1);
            const f32x2 vv = *(const f32x2*)(st + (4 * SUB1 + tt) * 64 + 2 * (rp & 31));
            const float v0 = urow ? vv[0] : 0.f, v1 = urow ? vv[1] : 0.f;
            f32x2 d0 = S0[0] * a2[0], d1 = S1[0] * a2[0];
#pragma unroll
            for (int c = 1; c < 4; ++c) { d0 += S0[c] * a2[c]; d1 += S1[c] * a2[c]; }
            const float sa0 = red8(d0[0] + d0[1]), sa1 = red8(d1[0] + d1[1]);
            const f32x2 sa0v = (f32x2){sa0, sa0}, sa1v = (f32x2){sa1, sa1}, v0v = (f32x2){v0, v0}, v1v = (f32x2){v1, v1};
            if (urow) {
#pragma unroll
                for (int c = 0; c < 4; ++c) {
                    S0[c] = S0[c] * w2[c] + (sa0v * b2[c] + v0v * k2[c]);
                    S1[c] = S1[c] * w2[c] + (sa1v * b2[c] + v1v * k2[c]);
                }
            } else {
#pragma unroll
                for (int c = 0; c < 4; ++c) {
                    S0[c] = S0[c] * w2[c] + sa0v * b2[c];
                    S1[c] = S1[c] * w2[c] + sa1v * b2[c];
                }
            }
        }
        __syncthreads();
    }
    float* dst = PU + ((size_t)(bh * NCH + ch) * 128 + 2 * rp) * 64 + cb * 8;
    *(f32x4*)(dst) = (f32x4){S0[0][0], S0[0][1], S0[1][0], S0[1][1]}; *(f32x4*)(dst + 4) = (f32x4){S0[2][0], S0[2][1], S0[3][0], S0[3][1]};
    *(f32x4*)(dst + 64) = (f32x4){S1[0][0], S1[0][1], S1[1][0], S1[1][1]}; *(f32x4*)(dst + 68) = (f32x4){S1[2][0], S1[2][1], S1[3][0], S1[3][1]};
}

typedef float f32x16 __attribute__((ext_vector_type(16)));
__device__ __forceinline__ float swap_sum32(float x) { const auto rr = __builtin_amdgcn_permlane32_swap(__float_as_uint(x), __float_as_uint(x), false, false); return __uint_as_float(rr[0]) + __uint_as_float(rr[1]); }
constexpr int SUBM = 32;
__device__ __forceinline__ void scan_pass1_pair(const Params& p, const bf16_t* P, float* PU, float* ldsf, int pair) {
    const int tid = otid(), ug = tid >> 8, utid = tid & 255, lane = tid & 63, wq = utid >> 6, l31 = lane & 31, hi = lane >> 5;
    const int unit = pair * 2 + ug;
    const int bh = unit / (NCH - 1), ch = unit % (NCH - 1), b = bh >> 4, h = bh & 15;
    float* st = ldsf + ug * (5 * SUBM * 64 + 512); float* cst = st + 5 * SUBM * 64;
    const int R = wq * 32 + l31;
    const bool urow = wq < 2;
    const int irow = R & 63;
    f32x16 T0, T1;
#pragma unroll
    for (int r = 0; r < 16; ++r) { const int j0 = 8 * (r >> 2) + 4 * hi + (r & 3); T0[r] = (!urow && j0 == irow) ? 1.f : 0.f; T1[r] = (!urow && 32 + j0 == irow) ? 1.f : 0.f; }
    const int rowbase = b * SEQ + ch * CHUNK;
    const int ptt = utid >> 3, pcb = utid & 7;
    load_cst(p, cst, h, utid); load_cst(p, cst, h, utid + 256);
    PrepRegs Rg; prep_issue(Rg, p, P, rowbase + ptt, h, pcb);
    __syncthreads();
    for (int sc = 0; sc < CHUNK / SUBM; ++sc) {
        prep_finish_norm<SUBM, false>(Rg, st, cst, ptt, pcb, ((rowbase + sc * SUBM + ptt) & (SEQ - 1)) == 0, h, lane, wq);
        __syncthreads();
        if (sc + 1 < CHUNK / SUBM) prep_issue(Rg, p, P, rowbase + (sc + 1) * SUBM + ptt, h, pcb);
#pragma unroll 4
        for (int tt = 0; tt < SUBM; ++tt) {
            const float* sA = st + (1 * SUBM + tt) * 64 + 4 * hi;
            f32x16 a0, a1;
#pragma unroll
            for (int q = 0; q < 4; ++q) {
                const f32x4 xa0 = *(const f32x4*)(sA + 8 * q), xa1 = *(const f32x4*)(sA + 32 + 8 * q);
#pragma unroll
                for (int e = 0; e < 4; ++e) { a0[4 * q + e] = xa0[e]; a1[4 * q + e] = xa1[e]; }
            }
            const float areg0 = st[((2 + hi) * SUBM + tt) * 64 + l31], areg1 = st[((2 + hi) * SUBM + tt) * 64 + 32 + l31];
            const float vi = st[(4 * SUBM + tt) * 64 + irow];
            const f32x16 pr = T0 * a0 + T1 * a1;
            const float s01 = ((pr[0] + pr[1]) + (pr[2] + pr[3])) + ((pr[4] + pr[5]) + (pr[6] + pr[7]));
            const float s23 = ((pr[8] + pr[9]) + (pr[10] + pr[11])) + ((pr[12] + pr[13]) + (pr[14] + pr[15]));
            const float sa = swap_sum32(s01 + s23);
            const float breg = hi ? (urow ? vi : 0.f) : sa;
            T0 = __builtin_amdgcn_mfma_f32_32x32x2f32(areg0, breg, T0, 0, 0, 0);
            T1 = __builtin_amdgcn_mfma_f32_32x32x2f32(areg1, breg, T1, 0, 0, 0);
        }
#pragma unroll
        for (int q = 0; q < 4; ++q) {
            const f32x4 g0 = *(const f32x4*)(st + 256 + 8 * q + 4 * hi), g1 = *(const f32x4*)(st + 256 + 32 + 8 * q + 4 * hi);
#pragma unroll
            for (int e = 0; e < 4; ++e) { T0[4 * q + e] *= g0[e]; T1[4 * q + e] *= g1[e]; }
        }
        __syncthreads();
    }
    float* dst = PU + ((size_t)(bh * NCH + ch) * 128 + R) * 64 + 4 * hi;
#pragma unroll
    for (int q = 0; q < 4; ++q) {
        *(f32x4*)(dst + 8 * q) = (f32x4){T0[4 * q], T0[4 * q + 1], T0[4 * q + 2], T0[4 * q + 3]};
        *(f32x4*)(dst + 32 + 8 * q) = (f32x4){T1[4 * q], T1[4 * q + 1], T1[4 * q + 2], T1[4 * q + 3]};
    }
}

__device__ __forceinline__ void scan_pass2_wave(const float* PU, float* SC, int wu, int lane) {
    const int bh = wu >> 6, i = wu & 63;
    float S = 0.f;
    float pc[64], uc;
    { const float* Uc = PU + (size_t)(bh * NCH) * 128 * 64; uc = Uc[i * 64 + lane];
#pragma unroll
      for (int m = 0; m < 64; ++m) pc[m] = Uc[64 * 64 + m * 64 + lane]; }
#pragma unroll 1
    for (int c = 0; c < NCH - 1; ++c) {
        float pn[64], un = 0.f;
        const int cn = (c + 1 < NCH - 1) ? c + 1 : c;
        { const float* Un = PU + (size_t)(bh * NCH + cn) * 128 * 64; un = Un[i * 64 + lane];
#pragma unroll
          for (int m = 0; m < 64; ++m) pn[m] = Un[64 * 64 + m * 64 + lane]; }
        float acc = uc, acc2 = 0.f;
#pragma unroll
        for (int m = 0; m < 64; m += 2) {
            acc += __int_as_float(__builtin_amdgcn_readlane(__float_as_int(S), m)) * pc[m];
            acc2 += __int_as_float(__builtin_amdgcn_readlane(__float_as_int(S), m + 1)) * pc[m + 1];
        }
        S = acc + acc2;
        SC[(size_t)(bh * NCH + c + 1) * 4096 + i * 64 + lane] = S;
        uc = un;
#pragma unroll
        for (int m = 0; m < 64; ++m) pc[m] = pn[m];
    }
}

template <bool IS_S>
__device__ __forceinline__ void scan_pass3_pair(const Params& p, const bf16_t* P, const float* SC, bf16_t* rwkv_o, float* ldsf, int pair) {
    const int tid = otid(), ug = tid >> 8, utid = tid & 255;
    const int unit = pair * 2 + ug;
    int h, row_base; const float* Sinit; float* Sfinal; const float* sprev = nullptr;
    constexpr int ntok = IS_S ? 1 : CHUNK;
    if (!IS_S) { const int bh = unit / NCH, ch = unit % NCH; h = bh & 15; row_base = (bh >> 4) * SEQ + ch * CHUNK;
        Sinit = ch ? SC + (size_t)(bh * NCH + ch) * 4096 : nullptr; Sfinal = (ch == NCH - 1) ? p.out + O_WKVP + (size_t)bh * 4096 : nullptr; }
    else { h = unit & 15; row_base = MP + (unit >> 4); Sinit = p.in[5] + (size_t)unit * 4096; Sfinal = p.out + O_WKVS + (size_t)unit * 4096; sprev = p.in[4] + (size_t)(unit >> 4) * RW; }
    float* st = ldsf + ug * (7 * SUB3 * 64 + 512); float* yb = st + 6 * SUB3 * 64; float* cst = yb + SUB3 * 64;
    const int rp = utid >> 3, cb = utid & 7;
    f32x2 S0[4], S1[4];
    if (Sinit) { const float* s = Sinit + (2 * rp) * 64 + cb * 8;
        const f32x4 a = *(const f32x4*)s, bq = *(const f32x4*)(s + 4), c = *(const f32x4*)(s + 64), d = *(const f32x4*)(s + 68);
        S0[0] = (f32x2){a[0], a[1]}; S0[1] = (f32x2){a[2], a[3]}; S0[2] = (f32x2){bq[0], bq[1]}; S0[3] = (f32x2){bq[2], bq[3]};
        S1[0] = (f32x2){c[0], c[1]}; S1[1] = (f32x2){c[2], c[3]}; S1[2] = (f32x2){d[0], d[1]}; S1[3] = (f32x2){d[2], d[3]}; }
    else {
#pragma unroll
        for (int c = 0; c < 4; ++c) { S0[c] = (f32x2){0.f, 0.f}; S1[c] = (f32x2){0.f, 0.f}; } }
    load_cst(p, cst, h, utid); load_cst(p, cst, h, utid + 256);
    constexpr int nsub = (ntok + SUB3 - 1) / SUB3;
    PrepRegs R;
    if (rp < ntok) prep_issue(R, p, P, row_base + rp, h, cb);
    __syncthreads();
    for (int sc = 0; sc < nsub; ++sc) {
        constexpr int nv = IS_S ? 1 : SUB3;
        const int row0 = row_base + sc * SUB3;
        prep_finish_norm<SUB3, true>(R, st, cst, rp, cb, ((row0 + rp) & (SEQ - 1)) == 0, h, tid & 63, utid >> 6);
        __syncthreads();
        u32x4 greg = (u32x4){0u, 0u, 0u, 0u};
        if (rp < nv) greg = *(const u32x4*)((const unsigned char*)p.out + (size_t)(row0 + rp) * 8192 + 6144 + (size_t)(h * 64 + cb * 8) * 2);
        if (!IS_S && sc + 1 < nsub) prep_issue(R, p, P, row0 + SUB3 + rp, h, cb);
#pragma unroll 4
        for (int tt = 0; tt < nv; ++tt) {
            f32x2 a2[4], b2[4], k2[4], r2[4];
            LD8S(a2, 1, SUB3); LD8S(b2, 2, SUB3); LD8S(k2, 3, SUB3); LD8S(r2, 5, SUB3);
            const f32x2 vv = *(const f32x2*)(st + (4 * SUB3 + tt) * 64 + 2 * rp);
            f32x2 d0 = S0[0] * a2[0], d1 = S1[0] * a2[0];
#pragma unroll
            for (int c = 1; c < 4; ++c) { d0 += S0[c] * a2[c]; d1 += S1[c] * a2[c]; }
            const float sa0 = red8(d0[0] + d0[1]), sa1 = red8(d1[0] + d1[1]);
            const f32x2 sa0v = (f32x2){sa0, sa0}, sa1v = (f32x2){sa1, sa1}, v0v = (f32x2){vv[0], vv[0]}, v1v = (f32x2){vv[1], vv[1]};
#pragma unroll
            for (int c = 0; c < 4; ++c) {
                S0[c] = S0[c] + (sa0v * b2[c] + v0v * k2[c]);
                S1[c] = S1[c] + (sa1v * b2[c] + v1v * k2[c]);
            }
            f32x2 y0 = S0[0] * r2[0], y1 = S1[0] * r2[0];
#pragma unroll
            for (int c = 1; c < 4; ++c) { y0 += S0[c] * r2[c]; y1 += S1[c] * r2[c]; }
            const float ys0 = red8(y0[0] + y0[1]), ys1 = red8(y1[0] + y1[1]);
            if (cb == 0) *(f32x2*)(yb + tt * 64 + 2 * rp) = (f32x2){ys0, ys1};
        }
        { const f32x4 g0 = *(const f32x4*)(st + 256 + cb * 8), g1 = *(const f32x4*)(st + 256 + cb * 8 + 4);
          const f32x2 ga = (f32x2){g0[0], g0[1]}, gb = (f32x2){g0[2], g0[3]}, gc = (f32x2){g1[0], g1[1]}, gd = (f32x2){g1[2], g1[3]};
          S0[0] *= ga; S0[1] *= gb; S0[2] *= gc; S0[3] *= gd; S1[0] *= ga; S1[1] *= gb; S1[2] *= gc; S1[3] *= gd; }
        __syncthreads();
        if (rp < nv) {
            const int tt = rp;
            const f32x4 ya = *(const f32x4*)(yb + tt * 64 + cb * 8), yb4 = *(const f32x4*)(yb + tt * 64 + cb * 8 + 4);
            const float y[8] = {ya[0], ya[1], ya[2], ya[3], yb4[0], yb4[1], yb4[2], yb4[3]};
            float s = 0.f;
#pragma unroll
            for (int i = 0; i < 8; ++i) s += y[i];
            const float mean = red8(s) * (1.f / 64.f);
            float q = 0.f;
#pragma unroll
            for (int i = 0; i < 8; ++i) { const float dd = y[i] - mean; q += dd * dd; }
            const float rstd = rsqrtf(red8(q) * (1.f / 64.f) + GN_EPS);
            const float* sr = st + (5 * SUB3 + tt) * 64 + cb * 8; const float* sk = st + (3 * SUB3 + tt) * 64 + cb * 8; const float* sv = st + (4 * SUB3 + tt) * 64 + cb * 8;
            const float* c5 = cst + 5 * 64 + cb * 8;
            float rkp = 0.f; float vs[8], gw[8], gb[8];
#pragma unroll
            for (int i = 0; i < 8; i += 4) { const f32x4 r4 = *(const f32x4*)(sr + i), k4 = *(const f32x4*)(sk + i), v4 = *(const f32x4*)(sv + i), c4 = *(const f32x4*)(c5 + i), w4 = *(const f32x4*)(c5 + 64 + i), b4 = *(const f32x4*)(c5 + 128 + i);
#pragma unroll
                for (int j = 0; j < 4; ++j) { rkp += r4[j] * k4[j] * c4[j]; vs[i + j] = v4[j]; gw[i + j] = w4[j]; gb[i + j] = b4[j]; } }
            const float rk = red8(rkp);
            float g[8]; unpack8(greg, g);
            float o[8];
#pragma unroll
            for (int i = 0; i < 8; ++i) o[i] = ((y[i] - mean) * rstd * gw[i] + gb[i] + rk * vs[i]) * g[i];
            u32x4 ow; ow.x = pk2(o[0], o[1]); ow.y = pk2(o[2], o[3]); ow.z = pk2(o[4], o[5]); ow.w = pk2(o[6], o[7]);
            *(u32x4*)(rwkv_o + (size_t)(row0 + tt) * AW + h * 64 + cb * 8) = ow;
        }
        __syncthreads();
    }
    if (Sfinal) { float* dst = Sfinal + (2 * rp) * 64 + cb * 8;
        *(f32x4*)(dst) = (f32x4){S0[0][0], S0[0][1], S0[1][0], S0[1][1]}; *(f32x4*)(dst + 4) = (f32x4){S0[2][0], S0[2][1], S0[3][0], S0[3][1]};
        *(f32x4*)(dst + 64) = (f32x4){S1[0][0], S1[0][1], S1[1][0], S1[1][1]}; *(f32x4*)(dst + 68) = (f32x4){S1[2][0], S1[2][1], S1[3][0], S1[3][1]}; }
}

__device__ __forceinline__ void sample_scan_wave(const Params& p, const bf16_t* P, bf16_t* rwkv_o, int wu, int lane) {
    const int b = wu >> 4, h = wu & 15, hj = h * 64 + lane, row = MP + b;
    const bf16_t* q = P + (size_t)row * LDP;
    const float* sp = p.in[4] + (size_t)b * RW;
    const float* mu = p.in[8];
    const float cr = bf2f(q[COL_R + hj]), ck = bf2f(q[COL_RK + hj]), cv = bf2f(q[COL_RV + hj]);
    const float rs = cr + (sp[hj] - cr) * mu[hj], ks = ck + (sp[1024 + hj] - ck) * mu[1024 + hj], vs = cv + (sp[2048 + hj] - cv) * mu[2048 + hj];
    const unsigned char* lw = (const unsigned char*)p.out + (size_t)row * 8192;
    const float w = ((const float*)lw)[hj];
    const float a = bf2f(((const bf16_t*)(lw + 4096))[hj]), g = bf2f(((const bf16_t*)(lw + 6144))[hj]);
    const float* Sin = p.in[5] + (size_t)wu * 4096 + lane * 64;
    float S[64];
#pragma unroll
    for (int c = 0; c < 64; c += 4) { const f32x4 t = *(const f32x4*)(Sin + c); S[c] = t[0]; S[c + 1] = t[1]; S[c + 2] = t[2]; S[c + 3] = t[3]; }
    const float kr = ks * p.in[14][hj];
    const float ss = wave_sum(kr * kr);
    const float kk = kr / fmaxf(sqrtf(ss), 1e-12f);
    const float na = -kk, bb = kk * a, kp = ks * (1.f + (a - 1.f) * p.in[15][hj]);
#define BC(x, c) __int_as_float(__builtin_amdgcn_readlane(__float_as_int(x), (c)))
    float sa0 = 0.f, sa1 = 0.f;
#pragma unroll
    for (int c = 0; c < 64; c += 2) { sa0 += S[c] * BC(na, c); sa1 += S[c + 1] * BC(na, c + 1); }
    const float sa = sa0 + sa1;
    float y0 = 0.f, y1 = 0.f;
#pragma unroll
    for (int c = 0; c < 64; c += 2) {
        S[c] = S[c] * BC(w, c) + (sa * BC(bb, c) + vs * BC(kp, c));
        S[c + 1] = S[c + 1] * BC(w, c + 1) + (sa * BC(bb, c + 1) + vs * BC(kp, c + 1));
        y0 += S[c] * BC(rs, c); y1 += S[c + 1] * BC(rs, c + 1);
    }
#undef BC
    const float y = y0 + y1;
    float* Sout = p.out + O_WKVS + (size_t)wu * 4096 + lane * 64;
#pragma unroll
    for (int c = 0; c < 64; c += 4) *(f32x4*)(Sout + c) = (f32x4){S[c], S[c + 1], S[c + 2], S[c + 3]};
    const float mean = wave_sum(y) * (1.f / 64.f);
    const float dy = y - mean;
    const float var = wave_sum(dy * dy) * (1.f / 64.f);
    const float rk = wave_sum(rs * kp * p.in[16][hj]);
    const float o = (dy * rsqrtf(var + GN_EPS) * p.in[17][hj] + p.in[18][hj] + rk * vs) * g;
    rwkv_o[(size_t)row * AW + hj] = (bf16_t)(pk2(o, 0.f) & 0xffffu);
}

__device__ __forceinline__ void ln_rows(float* Z, const float* g, const float* bt, bf16_t* Hb, int gw, int ngw, int lane) {
    for (int row = gw; row < MREAL; row += ngw) {
        float* zr = Z + (size_t)row * DM + lane * 4;
        f32x4 v[8]; float s = 0.f;
#pragma unroll
        for (int j = 0; j < 8; ++j) { v[j] = *(const f32x4*)(zr + j * 256); s += (v[j][0] + v[j][1]) + (v[j][2] + v[j][3]); }
        const float mean = wave_sum(s) * (1.f / DM); float s2 = 0.f;
#pragma unroll
        for (int j = 0; j < 8; ++j) { v[j] = v[j] - mean; s2 += (v[j][0] * v[j][0] + v[j][1] * v[j][1]) + (v[j][2] * v[j][2] + v[j][3] * v[j][3]); }
        const float rstd = rsqrtf(wave_sum(s2) * (1.f / DM) + LN_EPS);
#pragma unroll
        for (int j = 0; j < 8; ++j) {
            const f32x4 gv = *(const f32x4*)(g + j * 256 + lane * 4), bv = *(const f32x4*)(bt + j * 256 + lane * 4);
            const f32x4 o = v[j] * rstd * gv + bv;
            if (!Hb) *(f32x4*)(zr + j * 256) = o;
            if (Hb) { u32x2 w; w.x = pk2(o[0], o[1]); w.y = pk2(o[2], o[3]); *(u32x2*)(Hb + (size_t)row * DM + j * 256 + lane * 4) = w; }
        }
    }
}

#define XB_TMO      128
#define XB_XCNT(j)  (256  + 64 * (j))
#define XB_XSUB(j)  (1280 + 64 * (j))
#define XB_XGEN(j)  (2304 + 64 * (j))
#define XB_TOP      3328
#define XB_TOPGEN   3392
#define XCD_BAR_WORDS 3456
#define XB_SPIN_CAP (1u << 18)

__device__ __forceinline__ unsigned xb_ld(unsigned* p)              { return __hip_atomic_load(p, __ATOMIC_RELAXED, __HIP_MEMORY_SCOPE_AGENT); }
__device__ __forceinline__ unsigned xb_add(unsigned* p, unsigned v) { return __hip_atomic_fetch_add(p, v, __ATOMIC_RELAXED, __HIP_MEMORY_SCOPE_AGENT); }
__device__ __forceinline__ unsigned xb_xcc_id() { return (unsigned)__builtin_amdgcn_s_getreg((3 << 11) | 20) & 0xFu; }
#define XB_SPIN(cond, bar) do { unsigned _sp = 0; while (cond) { __builtin_amdgcn_s_sleep(1); \
    if ((++_sp & 255u) == 0u) { if (xb_ld(&(bar)[XB_TMO])) break; if (_sp > XB_SPIN_CAP) { atomicAdd(&(bar)[XB_TMO], 1u); break; } } } } while (0)

struct XcdBarrier {
    unsigned* bar; unsigned x;
    volatile PG8_LAS unsigned* st;
};

__device__ __forceinline__ XcdBarrier xcd_barrier_post(unsigned* bar, volatile PG8_LAS unsigned* st) {
    XcdBarrier b; b.bar = bar; b.x = xb_xcc_id(); b.st = st;
    if (threadIdx.x == 0) (void)xb_add(&bar[XB_XCNT(b.x)], 1u);
    return b;
}
__device__ __forceinline__ void xcd_barrier_complete(unsigned* bar, unsigned x, unsigned& nloc, unsigned& nx) {
    const unsigned G = gridDim.x * gridDim.y * gridDim.z;
    unsigned sum, cnt, mine, sp = 0u;
    for (;;) {
        sum = 0u; cnt = 0u; mine = 0u;
#pragma unroll
        for (unsigned j = 0; j < 16; ++j) { const unsigned c = xb_ld(&bar[XB_XCNT(j)]); sum += c; cnt += (c > 0u) ? 1u : 0u; mine = (j == x) ? c : mine; }
        if (sum == G) break;
        __builtin_amdgcn_s_sleep(1);
        if ((++sp & 255u) == 0u) { if (xb_ld(&bar[XB_TMO])) break; if (sp > XB_SPIN_CAP) { atomicAdd(&bar[XB_TMO], 1u); break; } }
    }
    nloc = mine > 0u ? mine : 1u; nx = cnt > 0u ? cnt : 1u;
}

__device__ __forceinline__ void xcd_barrier(const XcdBarrier& b) {
    asm volatile("s_waitcnt vmcnt(0)" ::: "memory");
    __syncthreads();
    if (threadIdx.x == 0) {
        unsigned* bar = b.bar;
        __builtin_amdgcn_s_waitcnt(0);
        unsigned nloc = b.st[0], nx = b.st[1];
        if (nloc == 0u) { xcd_barrier_complete(bar, b.x, nloc, nx); b.st[0] = nloc; b.st[1] = nx; }
        const unsigned old = xb_add(&bar[XB_XSUB(b.x)], 1u);
        const unsigned gen = old / nloc;
        if (old + 1u == (gen + 1u) * nloc) {
            __builtin_amdgcn_fence(__ATOMIC_RELEASE, "agent");
            asm volatile("s_waitcnt vmcnt(0)" ::: "memory");
            const unsigned og = xb_add(&bar[XB_TOP], 1u);
            const unsigned tg = og / nx;
            if (og + 1u == (tg + 1u) * nx) xb_add(&bar[XB_TOPGEN], 1u);
            else XB_SPIN(xb_ld(&bar[XB_TOPGEN]) == tg, bar);
            __builtin_amdgcn_fence(__ATOMIC_ACQUIRE, "agent");
            xb_add(&bar[XB_XGEN(b.x)], 1u);
            asm volatile("s_waitcnt vmcnt(0)" ::: "memory");
        } else {
            XB_SPIN(xb_ld(&bar[XB_XGEN(b.x)]) == gen, bar);
            __builtin_amdgcn_fence(__ATOMIC_ACQUIRE, "agent");
            asm volatile("s_waitcnt vmcnt(0)" ::: "memory");
        }
    }
    __syncthreads();
}

__device__ __forceinline__ void gsync(unsigned* flags, unsigned& gen) {
    asm volatile("s_waitcnt vmcnt(0) lgkmcnt(0)" ::: "memory");
    __syncthreads();
    gen += 1u;
    const unsigned tagk = 0x5EED0000u + gen;
    if (threadIdx.x == 0) {
        __builtin_amdgcn_fence(__ATOMIC_RELEASE, "agent");
        asm volatile("s_waitcnt vmcnt(0)" ::: "memory");
        __hip_atomic_store(flags + 32 * blockIdx.x, tagk, __ATOMIC_RELAXED, __HIP_MEMORY_SCOPE_AGENT);
    }
    if (threadIdx.x < gridDim.x) {
        unsigned* f = flags + 32 * threadIdx.x;
        for (;;) { const unsigned v = __hip_atomic_load(f, __ATOMIC_RELAXED, __HIP_MEMORY_SCOPE_AGENT); if (v == tagk || v == tagk + 1u) break; __builtin_amdgcn_s_sleep(2); }
    }
    __syncthreads();
    __builtin_amdgcn_fence(__ATOMIC_ACQUIRE, "agent");
    asm volatile("s_waitcnt vmcnt(0) lgkmcnt(0)" ::: "memory");
}

#ifndef PROBE_AT
#define PROBE_AT 0
#endif
__device__ __forceinline__ void probe_dump(const Params& p, const bf16_t* a, size_t na, const bf16_t* b, size_t nb) {
    const size_t gt = (size_t)blockIdx.x * NTHREADS + threadIdx.x, NGT = (size_t)gridDim.x * NTHREADS;
    for (size_t e = gt; e < O_END; e += NGT) {
        float v = 0.f;
        if (e < na) v = bf2f(a[e]); else if (e < na + nb) v = bf2f(b[e - na]);
        p.out[e] = v;
    }
}
__global__ void __launch_bounds__(NTHREADS, 2) mega_fwd(Params p) {
    extern __shared__ __attribute__((aligned(16))) unsigned char lds[];
    cg::grid_group grid = cg::this_grid();
    const int G = gridDim.x;
    unsigned char* ws = p.ws;
    bf16_t* Pm = (bf16_t*)(ws + WS_P);
    bf16_t* regA = (bf16_t*)(ws + WS_A);
    bf16_t* rwkv_o = (bf16_t*)(ws + WS_RWO);
    float* PU = (float*)(ws + WS_PU);
    float* SC = (float*)(ws + WS_SC);
    PG8_LAS unsigned char* ldsl = (PG8_LAS unsigned char*)lds;
    float* part = (float*)(ws + WS_PB); unsigned* cnt = (unsigned*)ws; PG8_LAS unsigned* tflag = (PG8_LAS unsigned*)(ldsl + 131072);

    unsigned* bar = (unsigned*)ws + 1024; unsigned gen = 0u;
    unsigned* xbar = (unsigned*)ws + 16384; volatile PG8_LAS unsigned* xst = (volatile PG8_LAS unsigned*)((PG8_LAS unsigned char*)lds + 131072 + 64);
    if (threadIdx.x == 0) { xst[0] = 0u; xst[1] = 0u; }
    __syncthreads();
    grid.sync();
    REP(0) { if (blockIdx.x == 0) { cnt[threadIdx.x] = 0u; for (int i = threadIdx.x; i < XCD_BAR_WORDS; i += NTHREADS) xbar[i] = 0u; }
    phase0(p, lds);
    gsync(bar, gen); }
    XcdBarrier xb = xcd_barrier_post(xbar, xst);
    REP(1) {
        pg8::Gemm g{regA, (const bf16_t*)(ws + WS_WIN), MP, LDP, DM, DM, DM};
        pg8::StaticOrder S; S.init(MP, LDP, G, (int)blockIdx.x);
        pg8::EpiP E{Pm};
        pg8::gemm_phase<pg8::EpiP, pg8::StaticOrder, true, true>(ldsl, g, S, E);
        pg8::Gemm gt{regA, (const bf16_t*)(ws + WS_WIN), MPAD, LDP, 512, DM, DM};
        pg8::TailOrder T{LDP / 256, 4, 4, G, (int)blockIdx.x, MP / 256, 1024, 1024, 0, 0};
        pg8::EpiTail<true, 0, 4> ET{{part, cnt + 0, LDP, 4, tflag, Pm, nullptr, nullptr, nullptr}};
        pg8::gemm_phase<pg8::EpiTail<true, 0, 4>, pg8::TailOrder, true, true>(ldsl, gt, T, ET);
    xcd_barrier(xb); }
    REP(2) { phase2(p, lds);
    xcd_barrier(xb); }
#if PROBE_AT == 2
    { const size_t gt = (size_t)blockIdx.x * NTHREADS + threadIdx.x, NGT = (size_t)gridDim.x * NTHREADS; for (size_t e = gt; e < (size_t)MREAL * 2048; e += NGT) { const unsigned w = __float_as_uint(p.out[e]); p.out[e] = (float)(w & 0xffffu) * 1e-3f + (float)(w >> 16) * 1e-3f + bf2f(regA[e >> 1]); } } return;
#endif
    REP(3) { for (int pr = blockIdx.x; pr < 16 * (NCH - 1); pr += G) scan_pass1_pair(p, Pm, PU, (float*)lds, pr);
    xcd_barrier(xb); }
    REP(4) { const int t4 = otid(); for (int wu = blockIdx.x * 8 + (t4 >> 6); wu < 32 * 64; wu += G * 8) scan_pass2_wave(PU, SC, wu, t4 & 63);
    for (int su = blockIdx.x * 8 + (t4 >> 6); su < MS * 16; su += G * 8) sample_scan_wave(p, Pm, rwkv_o, su, t4 & 63);
    xcd_barrier(xb); }
    REP(5) { for (int pr = blockIdx.x; pr < 32 * NCH / 2; pr += G) scan_pass3_pair<false>(p, Pm, SC, rwkv_o, (float*)lds, pr);
    xcd_barrier(xb); }
#if PROBE_AT == 5
    probe_dump(p, regA, (size_t)MREAL * AW, rwkv_o, (size_t)MREAL * AW); return;
#endif
    {
        pg8::StaticOrder S; S.init(MP, DM, G, (int)blockIdx.x, 8);
        { pg8::Gemm g{regA, (const bf16_t*)(ws + WS_WPA), MP, DM, AW, AW, AW};
          pg8::EpiGateA E{Pm, p.out};
          pg8::gemm_phase<pg8::EpiGateA, pg8::StaticOrder, true, true>(ldsl, g, S, E); }
        __threadfence();
        { pg8::Gemm g{rwkv_o, (const bf16_t*)(ws + WS_WPR), MP, DM, AW, AW, AW};
          pg8::EpiGateB E{Pm, p.out};
          pg8::gemm_phase<pg8::EpiGateB, pg8::StaticOrder, true, true>(ldsl, g, S, E);
          pg8::Gemm gt{regA, (const bf16_t*)(ws + WS_WPA), MPAD, DM, 256, AW, AW};
          pg8::TailOrder T{DM / 256, 4, 8, G, (int)blockIdx.x, MP / 256, 512, 512, (long)MPAD * AW * 2, (long)(WS_WPR - WS_WPA)};
          pg8::EpiTail<false, 1, 4> ET{{part, cnt + 64, DM, 8, tflag, Pm, nullptr, nullptr, nullptr}};
          pg8::gemm_phase<pg8::EpiTail<false, 1, 4>, pg8::TailOrder, true, true>(ldsl, gt, T, ET); }
    }
    xcd_barrier(xb);
    REP(7) {
        pg8::Gemm g{Pm + COL_GA, (const bf16_t*)(ws + WS_WOUT), MP, DM, DM, LDP, DM};
        pg8::StaticOrder S; S.init(MP, DM, G, (int)blockIdx.x);
        pg8::EpiResid E{p.in[0], p.in[1], p.out, nullptr};
        pg8::gemm_phase<pg8::EpiResid, pg8::StaticOrder, true, true>(ldsl, g, S, E);
        pg8::Gemm gt{Pm + COL_GA, (const bf16_t*)(ws + WS_WOUT), MPAD, DM, 256, LDP, DM};
        pg8::TailOrder T{DM / 256, 8, 8, G, (int)blockIdx.x, MP / 256, 512, 512, 0, 0};
        pg8::EpiTail<false, 2, 8> ET{{part, cnt + 128, DM, 8, tflag, Pm, p.in[1], p.out, nullptr}};
        pg8::gemm_phase<pg8::EpiTail<false, 2, 8>, pg8::TailOrder, true, true>(ldsl, gt, T, ET);
    xcd_barrier(xb); }
    { const int t8 = otid(); ln_rows(p.out, p.in[22], p.in[23], regA, blockIdx.x * 8 + (t8 >> 6), G * 8, t8 & 63); }
    xcd_barrier(xb);
    REP(9) {
        pg8::Gemm g{regA, (const bf16_t*)(ws + WS_WUP), MP, DFF, DM, DM, DM};
        pg8::StaticOrder S; S.init(MP, DFF, G, (int)blockIdx.x);
        pg8::EpiUp E{Pm};
        pg8::gemm_phase<pg8::EpiUp, pg8::StaticOrder, true, true>(ldsl, g, S, E);
        pg8::Gemm gt{regA, (const bf16_t*)(ws + WS_WUP), MPAD, DFF, 512, DM, DM};
        pg8::TailOrder T{DFF / 256, 4, 4, G, (int)blockIdx.x, MP / 256, 1024, 1024, 0, 0};
        pg8::EpiTail<true, 3, 4> ET{{part, cnt + 192, DFF, 4, tflag, Pm, nullptr, nullptr, nullptr}};
        pg8::gemm_phase<pg8::EpiTail<true, 3, 4>, pg8::TailOrder, true, true>(ldsl, gt, T, ET);
    xcd_barrier(xb); }
    {
        pg8::Gemm g{Pm, (const bf16_t*)(ws + WS_WDN), MP, DM, DFF, DFF, DFF};
        pg8::StaticOrder S; S.init(MP, DM, G, (int)blockIdx.x);
        pg8::EpiResid E{nullptr, nullptr, p.out, regA};
        pg8::gemm_phase<pg8::EpiResid, pg8::StaticOrder, true, true>(ldsl, g, S, E);
        pg8::Gemm gt{Pm, (const bf16_t*)(ws + WS_WDN), MPAD, DM, 512, DFF, DFF};
        pg8::TailOrder T{DM / 256, 16, 16, G, (int)blockIdx.x, MP / 256, 1024, 1024, 0, 0};
        pg8::EpiTail<false, 2, 16> ET{{part, cnt + 256, DM, 16, tflag, Pm, nullptr, p.out, regA}};
        pg8::gemm_phase<pg8::EpiTail<false, 2, 16>, pg8::TailOrder, true, true>(ldsl, gt, T, ET);
    }
    xcd_barrier(xb);
    { const int t11 = otid(); ln_rows(p.out, p.in[26], p.in[27], nullptr, blockIdx.x * 8 + (t11 >> 6), G * 8, t11 & 63); }
}

extern "C" void kernel_launch(void* const* d_in, const int* in_sizes, int n_in, void* d_out, int out_size, void* d_ws, size_t ws_size, hipStream_t stream) {
    static int grid = 0;
    if (grid == 0) {
        if (n_in != 28 || out_size != (int)O_END || ws_size < WS_END) { fprintf(stderr, "kernel_launch: unexpected shapes: n_in %d out %d ws %zu\n", n_in, out_size, ws_size); grid = -1; return; }
        int dev = 0, cus = 0, per_cu = 0;
        hipGetDevice(&dev);
        hipDeviceGetAttribute(&cus, hipDeviceAttributeMultiprocessorCount, dev);
        hipFuncSetAttribute((const void*)mega_fwd, hipFuncAttributeMaxDynamicSharedMemorySize, LDS_BYTES);
        hipOccupancyMaxActiveBlocksPerMultiprocessor(&per_cu, (const void*)mega_fwd, NTHREADS, LDS_BYTES);
        (void)hipGetLastError();
        if (per_cu < 1) per_cu = 1;
        grid = cus;
        if (grid <= 0) grid = 256;
    }
    if (grid < 0) return;
    Params prm{};
    for (int i = 0; i < 28; ++i) prm.in[i] = (const float*)d_in[i];
    prm.out = (float*)d_out; prm.ws = (unsigned char*)d_ws;
    void* args[] = {&prm};
    hipError_t e = hipLaunchCooperativeKernel((const void*)mega_fwd, dim3(grid), dim3(NTHREADS), args, LDS_BYTES, stream);
    if (e != hipSuccess) fprintf(stderr, "cooperative launch failed: %s (grid %d)\n", hipGetErrorString(e), grid);
}
```

```cpp
#include <hip/hip_runtime.h>
#include <hip/hip_cooperative_groups.h>
#include <cstdio>
#include <cstdint>
namespace cg = cooperative_groups;
__device__ __forceinline__ int otid() { int t = threadIdx.x; asm volatile("" : "+v"(t)); return t; }
namespace pg8 {
#define PG8_LAS __attribute__((address_space(3)))
typedef unsigned short bf16_t;
typedef short bf16x8 __attribute__((ext_vector_type(8)));
typedef float f32x4 __attribute__((ext_vector_type(4)));
typedef unsigned u32x4 __attribute__((ext_vector_type(4)));
constexpr int BM = 256, BK = 64, HALF = 128, HTB = HALF * BK * 2  , STAGE_BYTES = 8 * HTB, NXCD = 8, WGM = 4;

__host__ __device__ __forceinline__ int lds_byte(int r, int c) { const int st = (r >> 4) * 2 + (c >> 5), rr = r & 15, cc = c & 31, ob = rr * 64 + cc * 2; return st * 1024 + (ob ^ (((ob >> 9) & 1) << 5)); }
__host__ __device__ __forceinline__ void stage_rc(int b, int& R, int& C) { const int st = b / 1024, sb = b % 1024, swz = sb ^ (((sb >> 9) & 1) << 5); R = (st >> 1) * 16 + swz / 64; C = (st & 1) * 32 + (swz % 64) / 2; }
__host__ __device__ __forceinline__ int perm32(int rho) { const int n = rho >> 4, i = rho & 15; return 8 * (i >> 2) + 4 * n + (i & 3); }

struct Unit { int pm, pn, slot; long offA, offB; };
struct Gemm { const bf16_t* A; const bf16_t* Bt; int M, N, K, lda, ldb; };

struct StaticOrder {
    int nM, nN, nwg, G, c, wgm;
    __host__ __device__ void init(int M, int N, int G_, int c_, int wgm_ = WGM) { nM = M / BM; nN = N / BM; nwg = nM * nN; G = G_; c = c_; wgm = wgm_; }
    __host__ __device__ bool next(int i, Unit& u) const {
        const long L = (long)i * G + c; if (L >= nwg) return false;
        int wgid = (int)L; { const int q = nwg / NXCD, r = nwg % NXCD, xcd = wgid % NXCD, off = wgid / NXCD; wgid = (xcd < r ? xcd * (q + 1) : r * (q + 1) + (xcd - r) * q) + off; }
        const int nig = wgm * nN, gid = wgid / nig, fm = gid * wgm, gsz = (nM - fm) < wgm ? (nM - fm) : wgm;
        u.pm = fm + ((wgid % nig) % gsz); u.pn = (wgid % nig) / gsz; u.slot = 0; u.offA = 0; u.offB = 0; return true;
    }
    __device__ __forceinline__ void a_ready(const Unit&) const {}
    __device__ __forceinline__ void done(const Unit&) const {}
};
template <class Epi, class Sched, bool ALIGN_EPI = false, bool SP2 = false>
__device__ __forceinline__ void gemm_phase(PG8_LAS unsigned char* lds, const Gemm g, const Sched& S, const Epi& E) {
    const int tid = otid(), wid = __builtin_amdgcn_readfirstlane(tid >> 6), lane = tid & 63, wr = wid >> 2, wc = wid & 3, fr = lane & 15, fq = lane >> 4;
    const int K = g.K, nt = K / BK;
    unsigned voffA[2], voffB[2];
#pragma unroll
    for (int i = 0; i < 2; ++i) { int R, C; stage_rc(tid * 16 + i * 8192, R, C); const int Rb = Epi::PERM ? ((R & ~31) + perm32(R & 31)) : R;
        voffA[i] = (unsigned)(R * g.lda + C) * 2u; voffB[i] = (unsigned)(Rb * g.ldb + C) * 2u; }
    const size_t kstep = (size_t)(BK * 2);
    const size_t hstepA = (size_t)HALF * g.lda * 2, hstepB = (size_t)HALF * g.ldb * 2;
    const size_t tstepA = 2 * hstepA, tstepB = 2 * hstepB;
    const unsigned ldsw = (unsigned)wid * 1024u;
    const int aoff = lds_byte(wr * 64 + fr, fq * 8), boff = lds_byte(wc * 32 + fr, fq * 8);
#define PG8_SA(b, h) (((b) * 2 + (h)) * HTB)
#define PG8_SB(b, h) ((4 + (b) * 2 + (h)) * HTB)
#define PG8_STAGE(bufoff, gbase, voff) do { _Pragma("unroll") for (int _i = 0; _i < 2; ++_i) \
        __builtin_amdgcn_global_load_lds((const unsigned*)((const char*)(gbase) + (voff)[_i]), (PG8_LAS unsigned*)(lds + (bufoff) + ldsw + _i * 8192), 16, 0, 0); } while (0)
#define PG8_LDA(dst, b, h) do { _Pragma("unroll") for (int m = 0; m < 4; ++m) _Pragma("unroll") for (int k = 0; k < 2; ++k) dst[m][k] = *(const PG8_LAS bf16x8*)(lds + PG8_SA(b, h) + aoff + m * 2048 + k * 1024); } while (0)
#define PG8_LDB(dst, b, h) do { _Pragma("unroll") for (int n = 0; n < 2; ++n) _Pragma("unroll") for (int k = 0; k < 2; ++k) dst[n][k] = *(const PG8_LAS bf16x8*)(lds + PG8_SB(b, h) + boff + n * 2048 + k * 1024); } while (0)
#define PG8_MMA(ai, bj, At, Bt) do { __builtin_amdgcn_s_setprio(1); _Pragma("unroll") for (int m = 0; m < 4; ++m) _Pragma("unroll") for (int n = 0; n < 2; ++n) _Pragma("unroll") for (int k = 0; k < 2; ++k) \
        acc[ai][bj][m][n] = __builtin_amdgcn_mfma_f32_16x16x32_bf16(Bt[n][k], At[m][k], acc[ai][bj][m][n], 0, 0, 0); __builtin_amdgcn_s_setprio(0); } while (0)
#define PG8_WAIT_V(n) asm volatile("s_waitcnt vmcnt(" #n ")" ::: "memory")
#define PG8_WAIT_L(n) asm volatile("s_waitcnt lgkmcnt(" #n ")" ::: "memory")
#define PG8_BAR __builtin_amdgcn_s_barrier()
#define PG8_SCHED __builtin_amdgcn_sched_barrier(0)
    Unit cur, nxt; int ui = 0;
    if (!S.next(0, cur)) return;
    f32x4 acc[2][2][4][2];
#pragma unroll
    for (int a = 0; a < 2; ++a)
#pragma unroll
        for (int b = 0; b < 2; ++b)
#pragma unroll
            for (int m = 0; m < 4; ++m)
#pragma unroll
                for (int n = 0; n < 2; ++n) acc[a][b][m][n] = (f32x4){0.f, 0.f, 0.f, 0.f};
    bf16x8 At[4][2], B0[2][2], B1[2][2];
    const char* cA = (const char*)g.A + (size_t)cur.pm * tstepA + cur.offA; const char* cB = (const char*)g.Bt + (size_t)cur.pn * tstepB + cur.offB;
    S.a_ready(cur);
    if constexpr (SP2) {
        PG8_STAGE(PG8_SB(0, 0), cB, voffB); PG8_STAGE(PG8_SB(0, 1), cB + hstepB, voffB); PG8_STAGE(PG8_SA(0, 0), cA, voffA); PG8_STAGE(PG8_SA(0, 1), cA + hstepA, voffA);
        if (wr == 1) PG8_BAR;
        PG8_WAIT_V(2); PG8_BAR;
        PG8_STAGE(PG8_SB(1, 0), cB + kstep, voffB); PG8_STAGE(PG8_SA(1, 0), cA + kstep, voffA); PG8_STAGE(PG8_SB(1, 1), cB + hstepB + kstep, voffB);
        PG8_WAIT_V(6); PG8_BAR;
    } else {
        PG8_STAGE(PG8_SB(0, 0), cB, voffB); PG8_STAGE(PG8_SA(0, 0), cA, voffA); PG8_STAGE(PG8_SB(0, 1), cB + hstepB, voffB); PG8_STAGE(PG8_SA(0, 1), cA + hstepA, voffA);
        if (wr == 1) PG8_BAR;
        PG8_WAIT_V(4); PG8_BAR;
        PG8_STAGE(PG8_SB(1, 0), cB + kstep, voffB); PG8_STAGE(PG8_SA(1, 0), cA + kstep, voffA); PG8_STAGE(PG8_SB(1, 1), cB + hstepB + kstep, voffB);
        PG8_WAIT_V(6); PG8_BAR;
    }
    for (;;) {
        const bool has_next = S.next(ui + 1, nxt);
        const char* nA = has_next ? (const char*)g.A + (size_t)nxt.pm * tstepA + nxt.offA : cA; const char* nB = has_next ? (const char*)g.Bt + (size_t)nxt.pn * tstepB + nxt.offB : cB;
        for (int t = 0; t < nt; t += 2) {
            const bool last = (t == nt - 2);
            const char* a1 = cA + (size_t)(t + 1) * kstep;
            const char* a2 = last ? nA : cA + (size_t)(t + 2) * kstep; const char* b2 = last ? nB : cB + (size_t)(t + 2) * kstep;
            const char* a3 = a2 + kstep; const char* b3 = b2 + kstep;
            if (last && has_next) S.a_ready(nxt);
            if constexpr (SP2) {
            PG8_LDB(B0, 0, 0); PG8_LDB(B1, 0, 1); PG8_SCHED; PG8_LDA(At, 0, 0); PG8_STAGE(PG8_SA(1, 1), a1 + hstepA, voffA);
            PG8_WAIT_V(8); PG8_WAIT_L(0); PG8_BAR; PG8_MMA(0, 0, At, B0); PG8_MMA(0, 1, At, B1); PG8_BAR; PG8_SCHED;
            PG8_LDA(At, 0, 1); PG8_STAGE(PG8_SB(0, 0), b2, voffB); PG8_STAGE(PG8_SB(0, 1), b2 + hstepB, voffB); PG8_STAGE(PG8_SA(0, 0), a2, voffA);
            PG8_WAIT_V(8); PG8_WAIT_L(0); PG8_BAR; PG8_MMA(1, 0, At, B0); PG8_MMA(1, 1, At, B1); PG8_BAR; PG8_SCHED;
            PG8_LDB(B0, 1, 0); PG8_LDB(B1, 1, 1); PG8_SCHED; PG8_LDA(At, 1, 0); PG8_STAGE(PG8_SA(0, 1), a2 + hstepA, voffA);
            PG8_WAIT_V(8); PG8_WAIT_L(0); PG8_BAR; PG8_MMA(0, 0, At, B0); PG8_MMA(0, 1, At, B1); PG8_BAR; PG8_SCHED;
            PG8_LDA(At, 1, 1); PG8_STAGE(PG8_SB(1, 0), b3, voffB); PG8_STAGE(PG8_SB(1, 1), b3 + hstepB, voffB); PG8_STAGE(PG8_SA(1, 0), a3, voffA);
            PG8_WAIT_V(8); PG8_WAIT_L(0); PG8_BAR; PG8_MMA(1, 0, At, B0); PG8_MMA(1, 1, At, B1); PG8_BAR; PG8_SCHED;
            } else {
            PG8_LDB(B0, 0, 0); PG8_SCHED; PG8_LDA(At, 0, 0); PG8_STAGE(PG8_SA(1, 1), a1 + hstepA, voffA);
            PG8_WAIT_L(8); PG8_BAR; PG8_WAIT_L(0); PG8_MMA(0, 0, At, B0); PG8_BAR; PG8_SCHED;
            PG8_LDB(B1, 0, 1); PG8_STAGE(PG8_SB(0, 0), b2, voffB);
            PG8_BAR; PG8_WAIT_L(0); PG8_MMA(0, 1, At, B1); PG8_BAR;
            PG8_LDA(At, 0, 1); PG8_STAGE(PG8_SA(0, 0), a2, voffA);
            PG8_BAR; PG8_WAIT_L(0); PG8_MMA(1, 0, At, B0); PG8_BAR; PG8_SCHED;
            PG8_STAGE(PG8_SB(0, 1), b2 + hstepB, voffB);
            PG8_WAIT_V(6); PG8_BAR; PG8_MMA(1, 1, At, B1); PG8_BAR;
            PG8_LDB(B0, 1, 0); PG8_SCHED; PG8_LDA(At, 1, 0); PG8_STAGE(PG8_SA(0, 1), a2 + hstepA, voffA);
            PG8_WAIT_L(8); PG8_BAR; PG8_WAIT_L(0); PG8_MMA(0, 0, At, B0); PG8_BAR; PG8_SCHED;
            PG8_LDB(B1, 1, 1); PG8_STAGE(PG8_SB(1, 0), b3, voffB);
            PG8_BAR; PG8_WAIT_L(0); PG8_MMA(0, 1, At, B1); PG8_BAR;
            PG8_LDA(At, 1, 1); PG8_STAGE(PG8_SA(1, 0), a3, voffA);
            PG8_BAR; PG8_WAIT_L(0); PG8_MMA(1, 0, At, B0); PG8_BAR; PG8_SCHED;
            PG8_STAGE(PG8_SB(1, 1), b3 + hstepB, voffB);
            PG8_WAIT_V(6); PG8_BAR; PG8_MMA(1, 1, At, B1); PG8_BAR;
            }
        }
        if constexpr (ALIGN_EPI) { if (wr == 0) PG8_BAR; }
        if constexpr (!Epi::AFTER_DRAIN) { E(acc, cur, wr, wc, fr, fq); S.done(cur); }
        if (!has_next) break;
#pragma unroll
        for (int a = 0; a < 2; ++a)
#pragma unroll
            for (int b = 0; b < 2; ++b)
#pragma unroll
                for (int m = 0; m < 4; ++m)
#pragma unroll
                    for (int n = 0; n < 2; ++n) acc[a][b][m][n] = (f32x4){0.f, 0.f, 0.f, 0.f};
        cur = nxt; cA = nA; cB = nB; ++ui;
        if constexpr (ALIGN_EPI) { if (wr == 1) PG8_BAR; }
    }
    PG8_WAIT_V(0);
    if constexpr (!ALIGN_EPI) { if (wr == 0) PG8_BAR; }
    PG8_BAR;
    if constexpr (Epi::AFTER_DRAIN) { E.fused(acc, cur, wr, wc, fr, fq, lds, wid, lane); S.done(cur); }
#undef PG8_SA
#undef PG8_SB
#undef PG8_STAGE
#undef PG8_LDA
#undef PG8_LDB
#undef PG8_MMA
#undef PG8_WAIT_V
#undef PG8_WAIT_L
#undef PG8_BAR
#undef PG8_SCHED
}
}

typedef unsigned short bf16_t;
typedef short bf16x8 __attribute__((ext_vector_type(8)));
typedef short bf16x4 __attribute__((ext_vector_type(4)));
typedef float f32x4 __attribute__((ext_vector_type(4)));
typedef float f32x2 __attribute__((ext_vector_type(2)));
typedef unsigned u32x4 __attribute__((ext_vector_type(4)));
typedef unsigned u32x2 __attribute__((ext_vector_type(2)));

constexpr int DM = 2048, SEQ = 8192, NBATCH = 2, MP = NBATCH * SEQ, MS = 128, MREAL = MP + MS, MPAD = 16640;
constexpr int INW = 8992, LDP = 9216, DFF = 8192, AW = 1024;
constexpr int COL_Q = 0, COL_K = 1024, COL_V = 1280, COL_R = 1536, COL_RK = 2560, COL_RV = 3584, COL_WD = 4608, COL_AD = 4672, COL_GD = 4736, COL_GA = 4896, COL_GB = 6944;
constexpr int RW = 3360;
constexpr int NCH = 16, CHUNK = 512, SUB = 32;
constexpr float ALPHA = 1.189207115002721f;
constexpr float LN_EPS = 1e-5f, GN_EPS = 64e-5f;
constexpr int PAST_LEN = 16384;

constexpr size_t MiB = 1u << 20;
constexpr size_t WS_WIN = 1 * MiB, WS_PU = 1 * MiB, WS_WPA = 37 * MiB, WS_WPR = 41 * MiB, WS_WOUT = 45 * MiB, WS_WUP = 53 * MiB, WS_WDN = 85 * MiB, WS_LORA = 117 * MiB;
constexpr size_t WS_A = 118 * MiB, WS_RWO = WS_A + (size_t)MPAD * AW * 2, WS_P = 183 * MiB, WS_SC = 476 * MiB, WS_PB = 484 * MiB, WS_END = 512 * MiB;
static_assert(WS_A + (size_t)MPAD * DM * 2 <= WS_P && WS_P + (size_t)MPAD * LDP * 2 <= WS_SC, "ws map");
constexpr size_t O_YP = 0, O_YS = 33554432, O_KWP = 33816576, O_VWP = 33882112, O_SHP = 33947648, O_WKVP = 33954368, O_KWS = 34085440, O_VWS = 38279744, O_SHS = 42474048, O_WKVS = 42904128, O_END = 51292736;

constexpr int LDS_BYTES = 147456;
constexpr int NTHREADS = 512;

struct Params { const float* in[28]; float* out; unsigned char* ws; };
#ifndef DBL_MASK
#define DBL_MASK 0
#endif
#define REP(k) _Pragma("unroll") for (int rep_ = 0; rep_ < (((DBL_MASK) >> (k)) & 1) + 1; ++rep_)

typedef __bf16 bf16x2_t __attribute__((ext_vector_type(2)));
__device__ __forceinline__ unsigned pk2s(float lo, float hi) { const f32x2 v = {lo, hi}; const bf16x2_t bb = __builtin_convertvector(v, bf16x2_t); return __builtin_bit_cast(unsigned, bb); }
__device__ __forceinline__ unsigned pk2(float lo, float hi) { unsigned r; asm volatile("v_cvt_pk_bf16_f32 %0, %1, %2" : "=v"(r) : "v"(lo), "v"(hi)); return r; }
__device__ __forceinline__ float bf2f(unsigned short b) { return __uint_as_float(((unsigned)b) << 16); }
__device__ __forceinline__ float bflo(unsigned w) { return __uint_as_float(w << 16); }
__device__ __forceinline__ float bfhi(unsigned w) { return __uint_as_float(w & 0xffff0000u); }
__device__ __forceinline__ float sigmoidf_(float x) { return __builtin_amdgcn_rcpf(1.0f + __expf(-x)); }
__device__ __forceinline__ float wave_sum(float v) {
#pragma unroll
    for (int o = 1; o < 64; o <<= 1) v += __shfl_xor(v, o);
    return v;
}
__device__ __forceinline__ float dpp_f(float x, const int ctrl_sel) {
    int v = __float_as_int(x), r;
    if (ctrl_sel == 0) r = __builtin_amdgcn_update_dpp(0, v, 0xB1, 0xF, 0xF, true);
    else if (ctrl_sel == 1) r = __builtin_amdgcn_update_dpp(0, v, 0x4E, 0xF, 0xF, true);
    else r = __builtin_amdgcn_update_dpp(0, v, 0x141, 0xF, 0xF, true);
    return __int_as_float(r);
}
__device__ __forceinline__ float red8(float x) { x += dpp_f(x, 0); x += dpp_f(x, 1); x += dpp_f(x, 2); return x; }

namespace pg8 {

struct EpiP {
    static constexpr bool PERM = true, AFTER_DRAIN = false;
    bf16_t* P;
    __device__ __forceinline__ void operator()(const f32x4 (&acc)[2][2][4][2], const Unit& u, int wr, int wc, int fr, int fq) const {
        const int row0 = u.pm * BM + wr * 64 + fr;
        const int colt = u.pn * BM + wc * 32 + 8 * fq;
        const bool ropet = (u.pn < 5) && ((wc & 1) == 0);
        const float qs = (u.pn < 4) ? 0.125f : 1.0f;
        const float INV[8] = {1.0f, 0.1939227432012558f, 0.03760603070259094f, 0.007292664609849453f, 0.0014142135623842478f, 0.00027424818836152554f, 5.318296098266728e-05f, 1.0313386155758053e-05f};
#pragma unroll
        for (int ai = 0; ai < 2; ++ai)
#pragma unroll
            for (int m = 0; m < 4; ++m) {
                const int row = row0 + ai * HALF + m * 16;
                float cs[8], sn[8];
                if (ropet) {
                    const int pos = (row < MP) ? (row & (SEQ - 1)) : PAST_LEN;
#pragma unroll
                    for (int i = 0; i < 8; ++i) {
                        const float ang = (float)pos * INV[i];
                        double rev = (double)ang * 0.15915494309189535; rev -= __builtin_rint(rev);
                        const float rf = (float)rev;
                        cs[i] = __builtin_amdgcn_cosf(rf); sn[i] = __builtin_amdgcn_sinf(rf);
                    }
                }
                bf16_t* rowp = P + (size_t)row * LDP + colt;
#pragma unroll
                for (int bj = 0; bj < 2; ++bj) {
                    const f32x4 v0 = acc[ai][bj][m][0], v1 = acc[ai][bj][m][1];
                    float x[8] = {v0[0], v0[1], v0[2], v0[3], v1[0], v1[1], v1[2], v1[3]};
                    if (ropet) {
#pragma unroll
                        for (int i = 0; i < 8; ++i) {
                            const float other = __shfl_xor(x[i], 16);
                            const float rot = (fq == 0) ? (x[i] * cs[i] - other * sn[i]) : (x[i] * cs[i] + other * sn[i]);
                            x[i] = (fq < 2) ? rot : x[i];
                        }
                    }
                    const int col = colt + bj * HALF;
                    if (col >= COL_GA) {
#pragma unroll
                        for (int i = 0; i < 8; ++i) x[i] = sigmoidf_(x[i]);
                    }
                    u32x4 w; w.x = pk2(x[0] * qs, x[1] * qs); w.y = pk2(x[2] * qs, x[3] * qs); w.z = pk2(x[4] * qs, x[5] * qs); w.w = pk2(x[6] * qs, x[7] * qs);
                    *(u32x4*)(rowp + bj * HALF) = w;
                }
            }
    }
};

struct EpiGateA {
    static constexpr bool PERM = false, AFTER_DRAIN = false;
    bf16_t* P; float* U;
    __device__ __forceinline__ void operator()(const f32x4 (&acc)[2][2][4][2], const Unit& u, int wr, int wc, int fr, int fq) const {
        const int row0 = u.pm * BM + wr * 64 + fr, col0 = u.pn * BM + wc * 32 + 4 * fq;
#pragma unroll
        for (int ai = 0; ai < 2; ++ai)
#pragma unroll
            for (int m = 0; m < 4; ++m) {
                const int row = row0 + ai * HALF + m * 16;
                if (row < MREAL) {
#pragma unroll
                    for (int bj = 0; bj < 2; ++bj)
#pragma unroll
                        for (int n = 0; n < 2; ++n) {
                            const int col = col0 + bj * HALF + n * 16;
                            const u32x2 gw = *(const u32x2*)(P + (size_t)row * LDP + COL_GA + col);
                            const f32x4 a = acc[ai][bj][m][n];
                            u32x2 o; o.x = pk2(a[0] * bflo(gw.x), a[1] * bfhi(gw.x)); o.y = pk2(a[2] * bflo(gw.y), a[3] * bfhi(gw.y));
                            *(u32x2*)(P + (size_t)row * LDP + COL_GA + col) = o;
                        }
                }
            }
    }
};
struct EpiGateB {
    static constexpr bool PERM = false, AFTER_DRAIN = false;
    bf16_t* P; const float* U;
    __device__ __forceinline__ void operator()(const f32x4 (&acc)[2][2][4][2], const Unit& u, int wr, int wc, int fr, int fq) const {
        const int row0 = u.pm * BM + wr * 64 + fr, col0 = u.pn * BM + wc * 32 + 4 * fq;
#pragma unroll
        for (int ai = 0; ai < 2; ++ai)
#pragma unroll
            for (int m = 0; m < 4; ++m) {
                const int row = row0 + ai * HALF + m * 16;
                if (row < MREAL) {
#pragma unroll
                    for (int bj = 0; bj < 2; ++bj)
#pragma unroll
                        for (int n = 0; n < 2; ++n) {
                            const int col = col0 + bj * HALF + n * 16;
                            const u32x2 gw = *(const u32x2*)(P + (size_t)row * LDP + COL_GB + col);
                            const f32x4 a = acc[ai][bj][m][n];
                            const u32x2 uw = *(const u32x2*)(P + (size_t)row * LDP + COL_GA + col);
                            u32x2 o; o.x = pk2(bflo(uw.x) + a[0] * bflo(gw.x), bfhi(uw.x) + a[1] * bfhi(gw.x)); o.y = pk2(bflo(uw.y) + a[2] * bflo(gw.y), bfhi(uw.y) + a[3] * bfhi(gw.y));
                            *(u32x2*)(P + (size_t)row * LDP + COL_GA + col) = o;
                        }
                }
            }
    }
};
struct EpiResid {
    static constexpr bool PERM = false, AFTER_DRAIN = false;
    const float* xp; const float* xs; bf16_t* ZB; int ldz; const bf16_t* hb;
    __device__ __forceinline__ void operator()(const f32x4 (&acc)[2][2][4][2], const Unit& u, int wr, int wc, int fr, int fq) const {
        const int row0 = u.pm * BM + wr * 64 + fr, col0 = u.pn * BM + wc * 32 + 4 * fq;
#pragma unroll
        for (int ai = 0; ai < 2; ++ai)
#pragma unroll
            for (int m = 0; m < 4; ++m) {
                const int row = row0 + ai * HALF + m * 16;
                if (row < MREAL) {
                    const float* bp = xp ? ((row < MP) ? xp + (size_t)row * DM : xs + (size_t)(row - MP) * DM) : nullptr;
#pragma unroll
                    for (int bj = 0; bj < 2; ++bj)
#pragma unroll
                        for (int n = 0; n < 2; ++n) {
                            const int col = col0 + bj * HALF + n * 16;
                            f32x4 bs;
                            if (xp) bs = *(const f32x4*)(bp + col);
                            else { const u32x2 hw = *(const u32x2*)(hb + (size_t)row * DM + col); bs = (f32x4){bflo(hw.x), bfhi(hw.x), bflo(hw.y), bfhi(hw.y)}; }
                            const f32x4 z = bs * ALPHA + acc[ai][bj][m][n];
                            u32x2 zw; zw.x = pk2(z[0], z[1]); zw.y = pk2(z[2], z[3]);
                            *(u32x2*)(ZB + (size_t)row * ldz + col) = zw;
                        }
                }
            }
    }
};
struct EpiUp {
    static constexpr bool PERM = true, AFTER_DRAIN = false;
    bf16_t* U;
    __device__ __forceinline__ void operator()(const f32x4 (&acc)[2][2][4][2], const Unit& u, int wr, int wc, int fr, int fq) const {
        const int row0 = u.pm * BM + wr * 64 + fr, col0 = u.pn * BM + wc * 32 + 8 * fq;
#pragma unroll
        for (int ai = 0; ai < 2; ++ai)
#pragma unroll
            for (int m = 0; m < 4; ++m) {
                bf16_t* rowp = U + (size_t)(row0 + ai * HALF + m * 16) * DFF + col0;
#pragma unroll
                for (int bj = 0; bj < 2; ++bj) {
                    f32x4 v0 = acc[ai][bj][m][0], v1 = acc[ai][bj][m][1];
#pragma unroll
                    for (int i = 0; i < 4; ++i) { const float a = fmaxf(v0[i], 0.f), b = fmaxf(v1[i], 0.f); v0[i] = a * a; v1[i] = b * b; }
                    u32x4 w; w.x = pk2(v0[0], v0[1]); w.y = pk2(v0[2], v0[3]); w.z = pk2(v1[0], v1[1]); w.w = pk2(v1[2], v1[3]);
                    *(u32x4*)(rowp + bj * HALF) = w;
                }
            }
    }
};

struct TailOrder {
    int nN, KS, nslot, G, c, pm; long ksA, ksB, DA, DB;
    __device__ bool next(int i, Unit& u) const {
        const int L = i * G + c; if (L >= nN * nslot) return false;
        u.pm = pm; u.pn = L / nslot; u.slot = L % nslot; const int which = u.slot / KS, kk = u.slot % KS;
        u.offA = which * DA + kk * ksA; u.offB = which * DB + kk * ksB; return true;
    }
    __device__ __forceinline__ void a_ready(const Unit&) const {}
    __device__ __forceinline__ void done(const Unit&) const {}
};
struct TailArgs { float* part; unsigned* cnt; int N, nslot; PG8_LAS unsigned* flag; bf16_t* P; const float* base; bf16_t* ZB; int ldz; const bf16_t* hb; };
template <int KIND, int KS>
__device__ __forceinline__ void tail_finalize(const TailArgs& a, int pn) {
    const int t = threadIdx.x, cg = t & 15;
    const int col0 = pn * BM + cg * 16;
#pragma unroll 1
    for (int i = 0; i < 4; ++i) {
        const int row = (t >> 4) + 32 * i;
        const float* src = a.part + (size_t)row * a.N + col0;
        float x[16], y[16];
#pragma unroll
        for (int q = 0; q < 4; ++q) { f32x4 sa = (f32x4){0.f, 0.f, 0.f, 0.f}, sb = sa;
#pragma unroll
            for (int sl = 0; sl < KS; ++sl) sa += *(const f32x4*)(src + (size_t)sl * 128 * a.N + 4 * q);
            if (KIND == 1) {
#pragma unroll
                for (int sl = KS; sl < 2 * KS; ++sl) sb += *(const f32x4*)(src + (size_t)sl * 128 * a.N + 4 * q); }
#pragma unroll
            for (int j = 0; j < 4; ++j) { x[4 * q + j] = sa[j]; y[4 * q + j] = sb[j]; } }
        const size_t grow = (size_t)(MP + row);
        if (KIND == 0) {
            if (pn < 5 && (col0 & 63) == 0) {
                const float INV[8] = {1.0f, 0.1939227432012558f, 0.03760603070259094f, 0.007292664609849453f, 0.0014142135623842478f, 0.00027424818836152554f, 5.318296098266728e-05f, 1.0313386155758053e-05f};
#pragma unroll
                for (int k = 0; k < 8; ++k) { const float ang = (float)PAST_LEN * INV[k]; double rev = (double)ang * 0.15915494309189535; rev -= __builtin_rint(rev); const float rf = (float)rev;
                    const float cs = __builtin_amdgcn_cosf(rf), sn = __builtin_amdgcn_sinf(rf); const float x1 = x[k], x2 = x[k + 8]; x[k] = x1 * cs - x2 * sn; x[k + 8] = x2 * cs + x1 * sn; }
            }
            const float qs = (pn < 4) ? 0.125f : 1.0f;
            if (col0 >= COL_GA) {
#pragma unroll
                for (int k = 0; k < 16; ++k) x[k] = sigmoidf_(x[k]); }
            u32x4 w0, w1; w0.x = pk2(x[0] * qs, x[1] * qs); w0.y = pk2(x[2] * qs, x[3] * qs); w0.z = pk2(x[4] * qs, x[5] * qs); w0.w = pk2(x[6] * qs, x[7] * qs);
            w1.x = pk2(x[8] * qs, x[9] * qs); w1.y = pk2(x[10] * qs, x[11] * qs); w1.z = pk2(x[12] * qs, x[13] * qs); w1.w = pk2(x[14] * qs, x[15] * qs);
            *(u32x4*)(a.P + grow * LDP + col0) = w0; *(u32x4*)(a.P + grow * LDP + col0 + 8) = w1;
        } else if (KIND == 1) {
            const u32x4 ga0 = *(const u32x4*)(a.P + grow * LDP + COL_GA + col0), ga1 = *(const u32x4*)(a.P + grow * LDP + COL_GA + col0 + 8);
            const u32x4 gb0 = *(const u32x4*)(a.P + grow * LDP + COL_GB + col0), gb1 = *(const u32x4*)(a.P + grow * LDP + COL_GB + col0 + 8);
            float ga[16], gb[16];
            { float u8[8]; u8[0] = bflo(ga0.x); u8[1] = bfhi(ga0.x); u8[2] = bflo(ga0.y); u8[3] = bfhi(ga0.y); u8[4] = bflo(ga0.z); u8[5] = bfhi(ga0.z); u8[6] = bflo(ga0.w); u8[7] = bfhi(ga0.w);
#pragma unroll
              for (int k = 0; k < 8; ++k) ga[k] = u8[k];
              u8[0] = bflo(ga1.x); u8[1] = bfhi(ga1.x); u8[2] = bflo(ga1.y); u8[3] = bfhi(ga1.y); u8[4] = bflo(ga1.z); u8[5] = bfhi(ga1.z); u8[6] = bflo(ga1.w); u8[7] = bfhi(ga1.w);
#pragma unroll
              for (int k = 0; k < 8; ++k) ga[8 + k] = u8[k];
              u8[0] = bflo(gb0.x); u8[1] = bfhi(gb0.x); u8[2] = bflo(gb0.y); u8[3] = bfhi(gb0.y); u8[4] = bflo(gb0.z); u8[5] = bfhi(gb0.z); u8[6] = bflo(gb0.w); u8[7] = bfhi(gb0.w);
#pragma unroll
              for (int k = 0; k < 8; ++k) gb[k] = u8[k];
              u8[0] = bflo(gb1.x); u8[1] = bfhi(gb1.x); u8[2] = bflo(gb1.y); u8[3] = bfhi(gb1.y); u8[4] = bflo(gb1.z); u8[5] = bfhi(gb1.z); u8[6] = bflo(gb1.w); u8[7] = bfhi(gb1.w);
#pragma unroll
              for (int k = 0; k < 8; ++k) gb[8 + k] = u8[k]; }
            float o[16];
#pragma unroll
            for (int k = 0; k < 16; ++k) o[k] = x[k] * ga[k] + y[k] * gb[k];
            u32x4 w0, w1; w0.x = pk2(o[0], o[1]); w0.y = pk2(o[2], o[3]); w0.z = pk2(o[4], o[5]); w0.w = pk2(o[6], o[7]);
            w1.x = pk2(o[8], o[9]); w1.y = pk2(o[10], o[11]); w1.z = pk2(o[12], o[13]); w1.w = pk2(o[14], o[15]);
            *(u32x4*)(a.P + grow * LDP + COL_GA + col0) = w0; *(u32x4*)(a.P + grow * LDP + COL_GA + col0 + 8) = w1;
        } else if (KIND == 2) {
            float z[16];
#pragma unroll
            for (int q = 0; q < 4; ++q) { f32x4 bs;
                if (a.base) bs = *(const f32x4*)(a.base + (size_t)row * DM + col0 + 4 * q);
                else { const u32x2 hw = *(const u32x2*)(a.hb + grow * DM + col0 + 4 * q); bs = (f32x4){bflo(hw.x), bfhi(hw.x), bflo(hw.y), bfhi(hw.y)}; }
#pragma unroll
                for (int e = 0; e < 4; ++e) z[4 * q + e] = bs[e] * ALPHA + x[4 * q + e]; }
            u32x4 w0, w1; w0.x = pk2(z[0], z[1]); w0.y = pk2(z[2], z[3]); w0.z = pk2(z[4], z[5]); w0.w = pk2(z[6], z[7]);
            w1.x = pk2(z[8], z[9]); w1.y = pk2(z[10], z[11]); w1.z = pk2(z[12], z[13]); w1.w = pk2(z[14], z[15]);
            *(u32x4*)(a.ZB + grow * a.ldz + col0) = w0; *(u32x4*)(a.ZB + grow * a.ldz + col0 + 8) = w1;
        } else {
#pragma unroll
            for (int k = 0; k < 16; ++k) { const float r = fmaxf(x[k], 0.f); x[k] = r * r; }
            u32x4 w0, w1; w0.x = pk2(x[0], x[1]); w0.y = pk2(x[2], x[3]); w0.z = pk2(x[4], x[5]); w0.w = pk2(x[6], x[7]);
            w1.x = pk2(x[8], x[9]); w1.y = pk2(x[10], x[11]); w1.z = pk2(x[12], x[13]); w1.w = pk2(x[14], x[15]);
            *(u32x4*)(a.P + grow * DFF + col0) = w0; *(u32x4*)(a.P + grow * DFF + col0 + 8) = w1;
        }
    }
}
template <bool PERM_, int KIND, int KS> struct EpiTail {
    static constexpr bool PERM = PERM_, AFTER_DRAIN = false;
    TailArgs a;
    __device__ __forceinline__ void operator()(const f32x4 (&acc)[2][2][4][2], const Unit& u, int wr, int wc, int fr, int fq) const {
        const int cbase = u.pn * BM + wc * 32 + (PERM ? 8 * fq : 4 * fq);
#pragma unroll
        for (int m = 0; m < 4; ++m)
#pragma unroll
            for (int bj = 0; bj < 2; ++bj)
#pragma unroll
                for (int n = 0; n < 2; ++n)
                    *(f32x4*)(a.part + ((size_t)u.slot * 128 + wr * 64 + m * 16 + fr) * a.N + cbase + bj * HALF + (PERM ? 4 * n : 16 * n)) = acc[0][bj][m][n];
        __builtin_amdgcn_fence(__ATOMIC_RELEASE, "agent");
        asm volatile("s_waitcnt vmcnt(0) lgkmcnt(0)" ::: "memory");
        __builtin_amdgcn_s_barrier();
        if (threadIdx.x == 0) { const unsigned old = __hip_atomic_fetch_add(a.cnt + u.pn, 1u, __ATOMIC_RELAXED, __HIP_MEMORY_SCOPE_AGENT); a.flag[0] = (old == (unsigned)(a.nslot - 1)) ? 1u : 0u; }
        asm volatile("s_waitcnt vmcnt(0) lgkmcnt(0)" ::: "memory");
        __builtin_amdgcn_s_barrier();
        asm volatile("" ::: "memory");
        const bool last = a.flag[0] != 0u;
        if (last) {
            __builtin_amdgcn_fence(__ATOMIC_ACQUIRE, "agent");
            asm volatile("s_waitcnt vmcnt(0)" ::: "memory");
            tail_finalize<KIND, KS>(a, u.pn);
        }
    }
};
}

__device__ __forceinline__ void p0_transpose_item(const float* W, int K, int N, bf16_t* WT, float* scr, int item, int lane) {
    const int nblk = N / 32, kb = item / nblk, nb = item % nblk, k0 = 64 * kb, n0 = 32 * nb;
#pragma unroll 8
    for (int i = 0; i < 32; ++i) { const int kk = 2 * i + (lane >> 5); scr[kk * 33 + (lane & 31)] = W[(size_t)(k0 + kk) * N + n0 + (lane & 31)]; }
    asm volatile("s_waitcnt lgkmcnt(0)" ::: "memory");
    const int c = lane & 7;
#pragma unroll
    for (int j = 0; j < 4; ++j) { const int n = (lane >> 3) + 8 * j; const float* s = scr + (8 * c) * 33 + n;
        u32x4 o; o.x = pk2(s[0 * 33], s[1 * 33]); o.y = pk2(s[2 * 33], s[3 * 33]); o.z = pk2(s[4 * 33], s[5 * 33]); o.w = pk2(s[6 * 33], s[7 * 33]);
        *(u32x4*)(WT + (size_t)(n0 + n) * K + k0 + 8 * c) = o; }
    asm volatile("s_waitcnt lgkmcnt(0)" ::: "memory");
}

__device__ __forceinline__ void phase0(const Params& p, unsigned char* lds) {
    const int tid = otid(), lane = tid & 63, wv = tid >> 6;
    const int G = gridDim.x, gw = blockIdx.x * 8 + wv, NGW = G * 8;
    const long gt = (long)blockIdx.x * NTHREADS + tid, NGT = (long)G * NTHREADS;
    unsigned char* ws = p.ws;
    float* scr = (float*)(lds + wv * 16384);
    constexpr int I_IN = 32 * 281, I_PA = 16 * 64, I_OUT = 32 * 64, I_UP = 32 * 256, I_DN = 128 * 64;
    constexpr int NIT = I_IN + 2 * I_PA + I_OUT + I_UP + I_DN;
    for (int it = gw; it < NIT; it += NGW) {
        int r = it;
        if (r < I_IN) { p0_transpose_item(p.in[6], DM, INW, (bf16_t*)(ws + WS_WIN), scr, r, lane); continue; } r -= I_IN;
        if (r < I_PA) { p0_transpose_item(p.in[19], AW, DM, (bf16_t*)(ws + WS_WPA), scr, r, lane); continue; } r -= I_PA;
        if (r < I_PA) { p0_transpose_item(p.in[20], AW, DM, (bf16_t*)(ws + WS_WPR), scr, r, lane); continue; } r -= I_PA;
        if (r < I_OUT) { p0_transpose_item(p.in[21], DM, DM, (bf16_t*)(ws + WS_WOUT), scr, r, lane); continue; } r -= I_OUT;
        if (r < I_UP) { p0_transpose_item(p.in[24], DM, DFF, (bf16_t*)(ws + WS_WUP), scr, r, lane); continue; } r -= I_UP;
        p0_transpose_item(p.in[25], DFF, DM, (bf16_t*)(ws + WS_WDN), scr, r, lane);
    }
    { u32x4* z = (u32x4*)(ws + WS_WIN + (size_t)INW * DM * 2); const long n16 = (long)(LDP - INW) * DM * 2 / 16;
      for (long e = gt; e < n16; e += NGT) z[e] = (u32x4){0u, 0u, 0u, 0u}; }
    { bf16_t* WdT = (bf16_t*)(ws + WS_LORA); bf16_t* WaT = WdT + 1024 * 64; bf16_t* WgT = WaT + 1024 * 64;
      const float* Wd = p.in[10]; const float* Wa = p.in[12]; const float* Wg = p.in[13];
      for (long e = gt; e < 1024 * 64; e += NGT) { const int n = (int)(e >> 6), k = (int)(e & 63); WdT[e] = (bf16_t)(pk2(Wd[k * 1024 + n], 0.f) & 0xffffu); WaT[e] = (bf16_t)(pk2(Wa[k * 1024 + n], 0.f) & 0xffffu); }
      for (long e = gt; e < 1024 * 160; e += NGT) { const int n = (int)(e / 160), k = (int)(e % 160); WgT[e] = (bf16_t)(pk2(Wg[k * 1024 + n], 0.f) & 0xffffu); } }
    { bf16_t* Xb = (bf16_t*)(ws + WS_A); const float* xp = p.in[0]; const float* xs = p.in[1];
      for (long e = gt; e < (long)MPAD * 256; e += NGT) { const int row = (int)(e >> 8), c8 = (int)(e & 255) * 8;
          u32x4 o = (u32x4){0u, 0u, 0u, 0u};
          if (row < MREAL) { const float* src = (row < MP) ? xp + (size_t)row * DM + c8 : xs + (size_t)(row - MP) * DM + c8;
              const f32x4 a = *(const f32x4*)src, b = *(const f32x4*)(src + 4);
              o.x = pk2(a[0], a[1]); o.y = pk2(a[2], a[3]); o.z = pk2(b[0], b[1]); o.w = pk2(b[2], b[3]); }
          *(u32x4*)(Xb + (size_t)row * DM + c8) = o; } }
}

__device__ __forceinline__ void attn_prompt_unit(unsigned char* lds, const bf16_t* P, bf16_t* attn_o, const float* sinks, int unit) {
    const int qblk = unit & 63, kvh = (unit >> 6) & 3, b = unit >> 8;
    const int tid = otid(), lane = tid & 63, wid = tid >> 6, fr = lane & 15, fq = lane >> 4;
    bf16_t* Ks = (bf16_t*)lds;
    bf16_t* Vt = (bf16_t*)(lds + 256 * 144);
    const long row0 = (long)b * SEQ + (long)(qblk - 1) * 128;
    const long tokrow = (long)b * SEQ + (long)qblk * 128 + 16 * wid + fr;
    bf16x8 qf[4][2];
#pragma unroll
    for (int g = 0; g < 4; ++g) { const bf16_t* qp = P + (size_t)tokrow * LDP + COL_Q + (kvh * 4 + g) * 64 + fq * 8; qf[g][0] = *(const bf16x8*)(qp); qf[g][1] = *(const bf16x8*)(qp + 32); }
#pragma unroll
    for (int i = 0; i < 4; ++i) {
        const int ch = tid + i * NTHREADS; const int key = ch >> 3, c8 = ch & 7;
        u32x4 kv = (u32x4){0u, 0u, 0u, 0u}, vv = (u32x4){0u, 0u, 0u, 0u};
        if (qblk > 0 || key >= 128) {
            const bf16_t* src = P + (size_t)(row0 + key) * LDP + kvh * 64 + c8 * 8;
            kv = *(const u32x4*)(src + COL_K); vv = *(const u32x4*)(src + COL_V);
        }
        *(u32x4*)(Ks + key * 72 + c8 * 8) = kv;
        bf16_t* vd = Vt + (c8 * 8) * 264 + key;
        vd[0 * 264] = (bf16_t)(vv.x & 0xffffu); vd[1 * 264] = (bf16_t)(vv.x >> 16);
        vd[2 * 264] = (bf16_t)(vv.y & 0xffffu); vd[3 * 264] = (bf16_t)(vv.y >> 16);
        vd[4 * 264] = (bf16_t)(vv.z & 0xffffu); vd[5 * 264] = (bf16_t)(vv.z >> 16);
        vd[6 * 264] = (bf16_t)(vv.w & 0xffffu); vd[7 * 264] = (bf16_t)(vv.w >> 16);
    }
    __syncthreads();
    const int qrel = 128 + 16 * wid + fr;
    const int kb0 = wid & ~1;
    const float L2E = 1.4426950408889634f;
#pragma unroll
    for (int g = 0; g < 4; ++g) {
        const int head = kvh * 4 + g;
        const bf16x8 qf0 = qf[g][0], qf1 = qf[g][1];
        f32x4 s[10];
#pragma unroll
        for (int jb = 0; jb < 10; ++jb) {
            const bf16_t* kp = Ks + (16 * (kb0 + jb) + fr) * 72 + fq * 8;
            const bf16x8 k0 = *(const bf16x8*)(kp), k1 = *(const bf16x8*)(kp + 32);
            f32x4 a = (f32x4){0.f, 0.f, 0.f, 0.f};
            a = __builtin_amdgcn_mfma_f32_16x16x32_bf16(k0, qf0, a, 0, 0, 0);
            a = __builtin_amdgcn_mfma_f32_16x16x32_bf16(k1, qf1, a, 0, 0, 0);
            s[jb] = a;
        }
        const float sink = sinks[head];
        float mx = sink;
#pragma unroll
        for (int jb = 0; jb < 10; ++jb)
#pragma unroll
            for (int j = 0; j < 4; ++j) {
                const int kidx = 16 * (kb0 + jb) + 4 * fq + j;
                const bool ok = (kidx <= qrel) && (kidx > qrel - 128) && (qblk > 0 || kidx >= 128);
                const float v = ok ? s[jb][j] : -INFINITY;
                s[jb][j] = v; mx = fmaxf(mx, v);
            }
        mx = fmaxf(mx, __shfl_xor(mx, 16)); mx = fmaxf(mx, __shfl_xor(mx, 32));
        float l = 0.f;
#pragma unroll
        for (int jb = 0; jb < 10; ++jb)
#pragma unroll
            for (int j = 0; j < 4; ++j) { const float e = __builtin_amdgcn_exp2f((s[jb][j] - mx) * L2E); s[jb][j] = e; l += e; }
        l += __shfl_xor(l, 16); l += __shfl_xor(l, 32);
        l += __builtin_amdgcn_exp2f((sink - mx) * L2E);
        const float rl = 1.0f / l;
        f32x4 o[4];
#pragma unroll
        for (int db = 0; db < 4; ++db) o[db] = (f32x4){0.f, 0.f, 0.f, 0.f};
#pragma unroll
        for (int G2 = 0; G2 < 5; ++G2) {
            u32x4 pw; pw.x = pk2s(s[2 * G2][0], s[2 * G2][1]); pw.y = pk2s(s[2 * G2][2], s[2 * G2][3]); pw.z = pk2s(s[2 * G2 + 1][0], s[2 * G2 + 1][1]); pw.w = pk2s(s[2 * G2 + 1][2], s[2 * G2 + 1][3]);
            const bf16x8 pb = __builtin_bit_cast(bf16x8, pw);
#pragma unroll
            for (int db = 0; db < 4; ++db) {
                const bf16_t* vp = Vt + (16 * db + fr) * 264 + 16 * (kb0 + 2 * G2) + 4 * fq;
                const u32x2 v0 = *(const u32x2*)(vp), v1 = *(const u32x2*)(vp + 16);
                u32x4 vw; vw.x = v0.x; vw.y = v0.y; vw.z = v1.x; vw.w = v1.y;
                o[db] = __builtin_amdgcn_mfma_f32_16x16x32_bf16(__builtin_bit_cast(bf16x8, vw), pb, o[db], 0, 0, 0);
            }
        }
        bf16_t* op = attn_o + (size_t)tokrow * AW + head * 64 + 4 * fq;
#pragma unroll
        for (int db = 0; db < 4; ++db) { u32x2 w; w.x = pk2(o[db][0] * rl, o[db][1] * rl); w.y = pk2(o[db][2] * rl, o[db][3] * rl); *(u32x2*)(op + 16 * db) = w; }
    }
    __syncthreads();
}

__device__ __forceinline__ void attn_sample_unit(const Params& p, const bf16_t* P, bf16_t* attn_o, unsigned char* lds, int unit) {
    const int b = unit >> 2, kvh = unit & 3, tid = otid();
    float* Kc = (float*)lds;
    float* Vc = Kc + 128 * 68;
    float* Kn = Vc + 128 * 64;
    float* Vn = Kn + 64;
    float* qs = Vn + 64;
    float* sc = qs + 256;
    const float* ck = p.in[2] + ((size_t)b * 128 * 4 + kvh) * 64;
    const float* cv = p.in[3] + ((size_t)b * 128 * 4 + kvh) * 64;
    float* ok = p.out + O_KWS + ((size_t)b * 128 * 4 + kvh) * 64;
    float* ov = p.out + O_VWS + ((size_t)b * 128 * 4 + kvh) * 64;
    const bf16_t* prow = P + (size_t)(MP + b) * LDP;
    f32x4 kr[4], vr[4];
#pragma unroll
    for (int i = 0; i < 4; ++i) { const int idx = tid + i * NTHREADS, key = idx >> 4, c4 = (idx & 15) * 4;
        kr[i] = *(const f32x4*)(ck + (size_t)key * 256 + c4); vr[i] = *(const f32x4*)(cv + (size_t)key * 256 + c4); }
#pragma unroll
    for (int i = 0; i < 4; ++i) { const int idx = tid + i * NTHREADS, key = idx >> 4, c4 = (idx & 15) * 4;
        *(f32x4*)(Kc + key * 68 + c4) = kr[i]; *(f32x4*)(Vc + key * 64 + c4) = vr[i];
        if (key >= 1) { *(f32x4*)(ok + (size_t)(key - 1) * 256 + c4) = kr[i]; *(f32x4*)(ov + (size_t)(key - 1) * 256 + c4) = vr[i]; } }
    if (tid < 64) { const float kn = bf2f(prow[COL_K + kvh * 64 + tid]), vn = bf2f(prow[COL_V + kvh * 64 + tid]);
        Kn[tid] = kn; Vn[tid] = vn; ok[(size_t)127 * 256 + tid] = kn; ov[(size_t)127 * 256 + tid] = vn; }
    else if (tid < 320) { const int e = tid - 64; qs[e] = bf2f(prow[COL_Q + kvh * 256 + e]); }
    __syncthreads();
    { const int h = tid >> 7, key = tid & 127;
      const float* qh = qs + h * 64; const float* kp = (key == 0) ? Kn : Kc + key * 68;
      float s0 = 0.f, s1 = 0.f;
#pragma unroll
      for (int d = 0; d < 64; d += 8) { const f32x4 ka = *(const f32x4*)(kp + d), kb = *(const f32x4*)(kp + d + 4), qa = *(const f32x4*)(qh + d), qb = *(const f32x4*)(qh + d + 4);
          s0 += ka[0] * qa[0] + ka[1] * qa[1] + ka[2] * qa[2] + ka[3] * qa[3]; s1 += kb[0] * qb[0] + kb[1] * qb[1] + kb[2] * qb[2] + kb[3] * qb[3]; }
      sc[h * 132 + ((key == 0) ? 128 : key)] = s0 + s1; }
    __syncthreads();
    if (tid < 256) { const int h = tid >> 6, d = tid & 63; const float* sh = sc + h * 132;
        const float sink = p.in[7][kvh * 4 + h];
        float m = sink;
        for (int k = 1; k <= 128; ++k) m = fmaxf(m, sh[k]);
        float l = __expf(sink - m), o = 0.f;
#pragma unroll 4
        for (int k = 1; k < 128; ++k) { const float e = __expf(sh[k] - m); l += e; o += e * Vc[k * 64 + d]; }
        { const float e = __expf(sh[128] - m); l += e; o += e * Vn[d]; }
        attn_o[(size_t)(MP + b) * AW + (kvh * 4 + h) * 64 + d] = (bf16_t)(pk2(o / l, 0.f) & 0xffffu); }
    __syncthreads();
}

__device__ __forceinline__ void lerp8(const bf16_t* prow, const float* sprev, const float* mu, bool is_s, bool first, int col, float (&x)[8]) {
    const u32x4 c = *(const u32x4*)(prow + col);
    const float cur[8] = {bflo(c.x), bfhi(c.x), bflo(c.y), bfhi(c.y), bflo(c.z), bfhi(c.z), bflo(c.w), bfhi(c.w)};
    float pv[8];
    if (is_s) { const f32x4 a = *(const f32x4*)(sprev + col - COL_R), bq = *(const f32x4*)(sprev + col - COL_R + 4);
        pv[0] = a[0]; pv[1] = a[1]; pv[2] = a[2]; pv[3] = a[3]; pv[4] = bq[0]; pv[5] = bq[1]; pv[6] = bq[2]; pv[7] = bq[3]; }
    else if (first) {
#pragma unroll
        for (int i = 0; i < 8; ++i) pv[i] = 0.f; }
    else { const u32x4 q = *(const u32x4*)(prow - LDP + col);
        pv[0] = bflo(q.x); pv[1] = bfhi(q.x); pv[2] = bflo(q.y); pv[3] = bfhi(q.y); pv[4] = bflo(q.z); pv[5] = bfhi(q.z); pv[6] = bflo(q.w); pv[7] = bfhi(q.w); }
    const f32x4 m0 = *(const f32x4*)(mu + col - COL_R), m1 = *(const f32x4*)(mu + col - COL_R + 4);
    const float mm[8] = {m0[0], m0[1], m0[2], m0[3], m1[0], m1[1], m1[2], m1[3]};
#pragma unroll
    for (int i = 0; i < 8; ++i) x[i] = cur[i] + (pv[i] - cur[i]) * mm[i];
}

__device__ __forceinline__ void lora_wave_unit(const Params& p, const bf16_t* P, int wu, int nb0, int nbn, int lane) {
    const int fr = lane & 15, fq = lane >> 4;
    const int row = wu * 16 + fr;
    const bool is_s = row >= MP; const bool first = (row & (SEQ - 1)) == 0;
    const bf16_t* prow = P + (size_t)row * LDP;
    const float* sprev = p.in[4] + (size_t)(is_s ? row - MP : 0) * RW;
    const float* mu = p.in[8];
    bf16x8 actw[2], acta[2], actg[5];
#pragma unroll
    for (int kk = 0; kk < 2; ++kk) {
        float x[8]; lerp8(prow, sprev, mu, is_s, first, COL_WD + 32 * kk + 8 * fq, x);
#pragma unroll
        for (int i = 0; i < 8; ++i) { const float e = __expf(2.f * x[i]); x[i] = 1.f - 2.f / (e + 1.f); }
        u32x4 w; w.x = pk2(x[0], x[1]); w.y = pk2(x[2], x[3]); w.z = pk2(x[4], x[5]); w.w = pk2(x[6], x[7]); actw[kk] = __builtin_bit_cast(bf16x8, w);
        lerp8(prow, sprev, mu, is_s, first, COL_AD + 32 * kk + 8 * fq, x);
        w.x = pk2(x[0], x[1]); w.y = pk2(x[2], x[3]); w.z = pk2(x[4], x[5]); w.w = pk2(x[6], x[7]); acta[kk] = __builtin_bit_cast(bf16x8, w);
    }
#pragma unroll
    for (int kk = 0; kk < 5; ++kk) {
        float x[8]; lerp8(prow, sprev, mu, is_s, first, COL_GD + 32 * kk + 8 * fq, x);
#pragma unroll
        for (int i = 0; i < 8; ++i) x[i] = sigmoidf_(x[i]);
        u32x4 w; w.x = pk2s(x[0], x[1]); w.y = pk2s(x[2], x[3]); w.z = pk2s(x[4], x[5]); w.w = pk2s(x[6], x[7]); actg[kk] = __builtin_bit_cast(bf16x8, w);
    }
    const bf16_t* WdT = (const bf16_t*)(p.ws + WS_LORA); const bf16_t* WaT = WdT + 1024 * 64; const bf16_t* WgT = WaT + 1024 * 64;
    const float* w0 = p.in[9]; const float* a0 = p.in[11];
    unsigned char* lw = (unsigned char*)p.out + (size_t)row * 8192;
#define LORA_LOAD(WD, WA, WG, W0V, A0V, NB) do { const int c_ = (NB) * 16 + fr; \
        _Pragma("unroll") for (int kk = 0; kk < 2; ++kk) { WD[kk] = *(const bf16x8*)(WdT + c_ * 64 + kk * 32 + fq * 8); WA[kk] = *(const bf16x8*)(WaT + c_ * 64 + kk * 32 + fq * 8); } \
        _Pragma("unroll") for (int kk = 0; kk < 5; ++kk) WG[kk] = *(const bf16x8*)(WgT + c_ * 160 + kk * 32 + fq * 8); \
        W0V = *(const f32x4*)(w0 + (NB) * 16 + 4 * fq); A0V = *(const f32x4*)(a0 + (NB) * 16 + 4 * fq); } while (0)
#define LORA_COMPUTE(WD, WA, WG, W0V, A0V, NB) do { \
        f32x4 accw = (f32x4){0.f, 0.f, 0.f, 0.f}, acca = accw, accg = accw; \
        _Pragma("unroll") for (int kk = 0; kk < 2; ++kk) { \
            accw = __builtin_amdgcn_mfma_f32_16x16x32_bf16(WD[kk], actw[kk], accw, 0, 0, 0); \
            acca = __builtin_amdgcn_mfma_f32_16x16x32_bf16(WA[kk], acta[kk], acca, 0, 0, 0); } \
        _Pragma("unroll") for (int kk = 0; kk < 5; ++kk) accg = __builtin_amdgcn_mfma_f32_16x16x32_bf16(WG[kk], actg[kk], accg, 0, 0, 0); \
        const int cc = (NB) * 16 + 4 * fq; \
        f32x4 dec; float av[4]; \
        _Pragma("unroll") for (int j = 0; j < 4; ++j) { \
            const float xx = -(W0V[j] + accw[j]); \
            const float sp = fmaxf(xx, 0.f) + __logf(1.f + __expf(-fabsf(xx))); \
            dec[j] = __expf(-__expf(-sp - 0.5f)); \
            av[j] = sigmoidf_(A0V[j] + acca[j]); } \
        *(f32x4*)(lw + (size_t)cc * 4) = dec; \
        u32x2 aw; aw.x = pk2s(av[0], av[1]); aw.y = pk2s(av[2], av[3]);     *(u32x2*)(lw + 4096 + (size_t)cc * 2) = aw; \
        u32x2 gw; gw.x = pk2s(accg[0], accg[1]); gw.y = pk2s(accg[2], accg[3]); *(u32x2*)(lw + 6144 + (size_t)cc * 2) = gw; } while (0)
    bf16x8 wdA[2], waA[2], wgA[5], wdB[2], waB[2], wgB[5]; f32x4 w0A, a0A, w0B, a0B;
    LORA_LOAD(wdA, waA, wgA, w0A, a0A, nb0);
#pragma unroll 1
    for (int nb = nb0; nb < nb0 + nbn; nb += 2) {
        LORA_LOAD(wdB, waB, wgB, w0B, a0B, nb + 1);
        LORA_COMPUTE(wdA, waA, wgA, w0A, a0A, nb);
        { const int nn = (nb + 2 < nb0 + nbn) ? nb + 2 : nb; LORA_LOAD(wdA, waA, wgA, w0A, a0A, nn); }
        LORA_COMPUTE(wdB, waB, wgB, w0B, a0B, nb + 1);
    }
#undef LORA_LOAD
#undef LORA_COMPUTE
}

__device__ __forceinline__ void phase2(const Params& p, unsigned char* lds) {
    const int tid = otid(), lane = tid & 63, wv = tid >> 6;
    const int G = gridDim.x;
    const bf16_t* P = (const bf16_t*)(p.ws + WS_P);
    bf16_t* attn_o = (bf16_t*)(p.ws + WS_A);
    REP(10) { for (int task = blockIdx.x; task < 256; task += G) { const int wt = task * 8 + wv; lora_wave_unit(p, P, wt >> 1, (wt & 1) * 32, 32, lane); }
      if (wv == 0) for (int m = blockIdx.x; m < 256; m += G) { const int wt = 2048 + (m >> 4); lora_wave_unit(p, P, wt >> 1, (wt & 1) * 32 + (m & 15) * 2, 2, lane); } }
    REP(12) for (int task = blockIdx.x + 254 - ((blockIdx.x + 254) / G) * G; task < 512; task += G) attn_sample_unit(p, P, attn_o, lds, task);
    REP(11) for (int task = blockIdx.x; task < 512; task += G) attn_prompt_unit(lds, P, attn_o, p.in[7], task);
    const long gt = (long)blockIdx.x * NTHREADS + tid, NGT = (long)G * NTHREADS;
    for (long e = gt; e < 2 * 65536; e += NGT) {
        const int which = (int)(e >> 16), r = (int)(e & 65535), bb = r >> 15, s = (r >> 8) & 127, c = r & 255;
        const bf16_t* src = P + (size_t)(bb * SEQ + SEQ - 128 + s) * LDP + (which ? COL_V : COL_K) + c;
        p.out[(which ? O_VWP : O_KWP) + r] = bf2f(*src);
    }
    for (long e = gt; e < (long)(NBATCH + MS) * RW; e += NGT) {
        const int sq = (int)(e / RW), c = (int)(e % RW);
        const int row = (sq < NBATCH) ? sq * SEQ + SEQ - 1 : MP + (sq - NBATCH);
        const float v = bf2f(P[(size_t)row * LDP + COL_R + c]);
        if (sq < NBATCH) p.out[O_SHP + (size_t)sq * RW + c] = v; else p.out[O_SHS + (size_t)(sq - NBATCH) * RW + c] = v;
    }
}

struct PrepRegs { u32x4 cr, ck, cv, pr, pk, pv, a; f32x4 w0, w1; };
__device__ __forceinline__ void unpack8(const u32x4 c, float (&x)[8]) { x[0] = bflo(c.x); x[1] = bfhi(c.x); x[2] = bflo(c.y); x[3] = bfhi(c.y); x[4] = bflo(c.z); x[5] = bfhi(c.z); x[6] = bflo(c.w); x[7] = bfhi(c.w); }

__device__ __forceinline__ void prep_issue(PrepRegs& R, const Params& p, const bf16_t* P, int row, int h, int cb) {
    const bf16_t* q = P + (size_t)row * LDP + h * 64 + cb * 8;
    const bf16_t* qp = (row > 0) ? q - LDP : q;
    R.cr = *(const u32x4*)(q + COL_R); R.ck = *(const u32x4*)(q + COL_RK); R.cv = *(const u32x4*)(q + COL_RV);
    R.pr = *(const u32x4*)(qp + COL_R); R.pk = *(const u32x4*)(qp + COL_RK); R.pv = *(const u32x4*)(qp + COL_RV);
    const unsigned char* lw = (const unsigned char*)p.out + (size_t)row * 8192;
    R.w0 = *(const f32x4*)(lw + (size_t)(h * 64 + cb * 8) * 4); R.w1 = *(const f32x4*)(lw + (size_t)(h * 64 + cb * 8) * 4 + 16);
    R.a = *(const u32x4*)(lw + 4096 + (size_t)(h * 64 + cb * 8) * 2);
}
template <int SUBN, bool WITH_R>
__device__ __forceinline__ void prep_finish(const PrepRegs& R, float* st, const float* cst, int tt, int cb, bool zero_prev, const float* sprev  , int h) {
    float cr[8], ck[8], cv[8], pr[8], pk[8], pv[8], a[8];
    unpack8(R.cr, cr); unpack8(R.ck, ck); unpack8(R.cv, cv); unpack8(R.a, a);
    if (sprev) {
        const float* s0 = sprev + h * 64 + cb * 8;
        const f32x4 r0 = *(const f32x4*)(s0), r1 = *(const f32x4*)(s0 + 4), k0 = *(const f32x4*)(s0 + 1024), k1 = *(const f32x4*)(s0 + 1028), v0 = *(const f32x4*)(s0 + 2048), v1 = *(const f32x4*)(s0 + 2052);
#pragma unroll
        for (int i = 0; i < 4; ++i) { pr[i] = r0[i]; pr[i + 4] = r1[i]; pk[i] = k0[i]; pk[i + 4] = k1[i]; pv[i] = v0[i]; pv[i + 4] = v1[i]; }
    } else { unpack8(R.pr, pr); unpack8(R.pk, pk); unpack8(R.pv, pv);
        if (zero_prev) {
#pragma unroll
            for (int i = 0; i < 8; ++i) { pr[i] = 0.f; pk[i] = 0.f; pv[i] = 0.f; } } }
    const float* c0 = cst + cb * 8;
    float mur[8], muk[8], muv[8], kkc[8], kac[8];
#pragma unroll
    for (int i = 0; i < 8; i += 4) {
        const f32x4 m0 = *(const f32x4*)(c0 + i), m1 = *(const f32x4*)(c0 + 64 + i), m2 = *(const f32x4*)(c0 + 128 + i), m3 = *(const f32x4*)(c0 + 192 + i), m4 = *(const f32x4*)(c0 + 256 + i);
#pragma unroll
        for (int j = 0; j < 4; ++j) { mur[i + j] = m0[j]; muk[i + j] = m1[j]; muv[i + j] = m2[j]; kkc[i + j] = m3[j]; kac[i + j] = m4[j]; }
    }
    const float w[8] = {R.w0[0], R.w0[1], R.w0[2], R.w0[3], R.w1[0], R.w1[1], R.w1[2], R.w1[3]};
    float rs[8], ks[8], vs[8], kr[8]; float ss = 0.f;
#pragma unroll
    for (int i = 0; i < 8; ++i) { rs[i] = cr[i] + (pr[i] - cr[i]) * mur[i]; ks[i] = ck[i] + (pk[i] - ck[i]) * muk[i]; vs[i] = cv[i] + (pv[i] - cv[i]) * muv[i]; kr[i] = ks[i] * kkc[i]; ss += kr[i] * kr[i]; }
    ss = red8(ss);
    const float rn = __builtin_amdgcn_rsqf(fmaxf(ss, 1e-24f));
    float na[8], bb[8], kp[8];
#pragma unroll
    for (int i = 0; i < 8; ++i) { const float kk = kr[i] * rn; na[i] = -kk; bb[i] = kk * a[i]; kp[i] = ks[i] * (1.f + (a[i] - 1.f) * kac[i]); }
    float* d = st + tt * 64 + cb * 8;
#define ST8(arr, x) do { *(f32x4*)(d + (arr) * SUBN * 64) = (f32x4){x[0], x[1], x[2], x[3]}; *(f32x4*)(d + (arr) * SUBN * 64 + 4) = (f32x4){x[4], x[5], x[6], x[7]}; } while (0)
    ST8(0, w); ST8(1, na); ST8(2, bb); ST8(3, kp); ST8(4, vs);
    if (WITH_R) ST8(5, rs);
#undef ST8
}
template <int SUBN, bool WITH_R>
__device__ __forceinline__ void prep_finish_norm(const PrepRegs& R, float* st, const float* cst, int tt, int cb, bool zero_prev, int h, int lane, int wq) {
    const float* sprev = nullptr;
    float cr[8], ck[8], cv[8], pr[8], pk[8], pv[8], a[8];
    unpack8(R.cr, cr); unpack8(R.ck, ck); unpack8(R.cv, cv); unpack8(R.a, a);
    if (sprev) {
        const float* s0 = sprev + h * 64 + cb * 8;
        const f32x4 r0 = *(const f32x4*)(s0), r1 = *(const f32x4*)(s0 + 4), k0 = *(const f32x4*)(s0 + 1024), k1 = *(const f32x4*)(s0 + 1028), v0 = *(const f32x4*)(s0 + 2048), v1 = *(const f32x4*)(s0 + 2052);
#pragma unroll
        for (int i = 0; i < 4; ++i) { pr[i] = r0[i]; pr[i + 4] = r1[i]; pk[i] = k0[i]; pk[i + 4] = k1[i]; pv[i] = v0[i]; pv[i + 4] = v1[i]; }
    } else { unpack8(R.pr, pr); unpack8(R.pk, pk); unpack8(R.pv, pv);
        if (zero_prev) {
#pragma unroll
            for (int i = 0; i < 8; ++i) { pr[i] = 0.f; pk[i] = 0.f; pv[i] = 0.f; } } }
    const float* c0 = cst + cb * 8;
    float mur[8], muk[8], muv[8], kkc[8], kac[8];
#pragma unroll
    for (int i = 0; i < 8; i += 4) {
        const f32x4 m0 = *(const f32x4*)(c0 + i), m1 = *(const f32x4*)(c0 + 64 + i), m2 = *(const f32x4*)(c0 + 128 + i), m3 = *(const f32x4*)(c0 + 192 + i), m4 = *(const f32x4*)(c0 + 256 + i);
#pragma unroll
        for (int j = 0; j < 4; ++j) { mur[i + j] = m0[j]; muk[i + j] = m1[j]; muv[i + j] = m2[j]; kkc[i + j] = m3[j]; kac[i + j] = m4[j]; }
    }
    const float w[8] = {R.w0[0], R.w0[1], R.w0[2], R.w0[3], R.w1[0], R.w1[1], R.w1[2], R.w1[3]};
    float rs[8], ks[8], vs[8], kr[8]; float ss = 0.f;
#pragma unroll
    for (int i = 0; i < 8; ++i) { rs[i] = cr[i] + (pr[i] - cr[i]) * mur[i]; ks[i] = ck[i] + (pk[i] - ck[i]) * muk[i]; vs[i] = cv[i] + (pv[i] - cv[i]) * muv[i]; kr[i] = ks[i] * kkc[i]; ss += kr[i] * kr[i]; }
    ss = red8(ss);
    const float rn = __builtin_amdgcn_rsqf(fmaxf(ss, 1e-24f));
    float na[8], bb[8], kp[8];
#pragma unroll
    for (int i = 0; i < 8; ++i) { const float kk = kr[i] * rn; na[i] = -kk; bb[i] = kk * a[i]; kp[i] = ks[i] * (1.f + (a[i] - 1.f) * kac[i]); }
    float g[8];
#pragma unroll
    for (int i = 0; i < 8; ++i) g[i] = w[i];
#pragma unroll
    for (int d8 = 8; d8 < 64; d8 <<= 1) {
#pragma unroll
        for (int i = 0; i < 8; ++i) { const float t = __shfl_up(g[i], d8); g[i] = (lane >= d8) ? g[i] * t : g[i]; }
    }
    float* tot = st;
    if ((lane >> 3) == 7) { *(f32x4*)(tot + wq * 64 + cb * 8) = (f32x4){g[0], g[1], g[2], g[3]}; *(f32x4*)(tot + wq * 64 + cb * 8 + 4) = (f32x4){g[4], g[5], g[6], g[7]}; }
    __syncthreads();
#pragma unroll
    for (int w_ = 0; w_ < 3; ++w_) {
        if (w_ < wq) { const f32x4 t0 = *(const f32x4*)(tot + w_ * 64 + cb * 8), t1 = *(const f32x4*)(tot + w_ * 64 + cb * 8 + 4);
#pragma unroll
            for (int i = 0; i < 4; ++i) { g[i] *= t0[i]; g[i + 4] *= t1[i]; } }
    }
    if (tt == SUBN - 1) { *(f32x4*)(tot + 256 + cb * 8) = (f32x4){g[0], g[1], g[2], g[3]}; *(f32x4*)(tot + 256 + cb * 8 + 4) = (f32x4){g[4], g[5], g[6], g[7]}; }
#pragma unroll
    for (int i = 0; i < 8; ++i) { const float inv = __builtin_amdgcn_rcpf(g[i]); const float gex = g[i] * __builtin_amdgcn_rcpf(w[i]); na[i] *= gex; bb[i] *= inv; kp[i] *= inv; rs[i] *= g[i]; }
    float* d = st + tt * 64 + cb * 8;
#define ST8(arr, x) do { *(f32x4*)(d + (arr) * SUBN * 64) = (f32x4){x[0], x[1], x[2], x[3]}; *(f32x4*)(d + (arr) * SUBN * 64 + 4) = (f32x4){x[4], x[5], x[6], x[7]}; } while (0)
    ST8(1, na); ST8(2, bb); ST8(3, kp); ST8(4, vs);
    if (WITH_R) ST8(5, rs);
#undef ST8
}

__device__ __forceinline__ void load_cst(const Params& p, float* cst, int h, int utid) {
    const int arr = utid >> 6, j = utid & 63;
    if (arr < 8) { const float* src = (arr < 3) ? p.in[8] + arr * 1024 : (arr == 3) ? p.in[14] : (arr == 4) ? p.in[15] : (arr == 5) ? p.in[16] : (arr == 6) ? p.in[17] : p.in[18];
        cst[arr * 64 + j] = src[h * 64 + j]; }
}

#define LD8S(dst, arr, SUBN) do { const f32x4 _a = *(const f32x4*)(st + ((arr) * SUBN + tt) * 64 + cb * 8), _b = *(const f32x4*)(st + ((arr) * SUBN + tt) * 64 + cb * 8 + 4); \
    dst[0] = (f32x2){_a[0], _a[1]}; dst[1] = (f32x2){_a[2], _a[3]}; dst[2] = (f32x2){_b[0], _b[1]}; dst[3] = (f32x2){_b[2], _b[3]}; } while (0)

constexpr int SUB1 = 64, SUB3 = 32;
__device__ __forceinline__ void scan_pass1_unit(const Params& p, const bf16_t* P, float* PU, float* ldsf, int unit) {
    const int bh = unit / (NCH - 1), ch = unit % (NCH - 1), b = bh >> 4, h = bh & 15;
    const int tid = otid();
    const int rp = tid >> 3, cb = tid & 7;
    float* st = ldsf; float* cst = ldsf + 5 * SUB1 * 64;
    f32x2 S0[4], S1[4];
#pragma unroll
    for (int c = 0; c < 4; ++c) {
        const int c0 = cb * 8 + 2 * c, i0 = 2 * rp - 64, i1 = 2 * rp - 63;
        S0[c] = (f32x2){(c0 == i0) ? 1.f : 0.f, (c0 + 1 == i0) ? 1.f : 0.f};
        S1[c] = (f32x2){(c0 == i1) ? 1.f : 0.f, (c0 + 1 == i1) ? 1.f : 0.f};
    }
    const bool urow = rp < 32;
    const int rowbase = b * SEQ + ch * CHUNK;
    load_cst(p, cst, h, tid);
    PrepRegs R; prep_issue(R, p, P, rowbase + rp, h, cb);
    __syncthreads();
    for (int sc = 0; sc < CHUNK / SUB1; ++sc) {
        prep_finish<SUB1, false>(R, st, cst, rp, cb, ((rowbase + sc * SUB1 + rp) & (SEQ - 1)) == 0, nullptr, h);
        __syncthreads();
        if (sc + 1 < CHUNK / SUB1) prep_issue(R, p, P, rowbase + (sc + 1) * SUB1 + rp, h, cb);
#pragma unroll 2
        for (int tt = 0; tt < SUB1; ++tt) {
            f32x2 w2[4], a2[4], b2[4], k2[4];
            LD8S(w2, 0, SUB1); LD8S(a2, 1, SUB1); LD8S(b2, 2, SUB1); LD8S(k2, 3, SUB1);
            const f32x2 vv = *(const f32x2*)(st + (4 * SUB1 + tt) * 64 + 2 * (rp & 31));
            const float v0 = urow ? vv[0] : 0.f, v1 = urow ? vv[1] : 0.f;
            f32x2 d0 = S0[0] * a2[0], d1 = S1[0] * a2[0];
#pragma unroll
            for (int c = 1; c < 4; ++c) { d0 += S0[c] * a2[c]; d1 += S1[c] * a2[c]; }
            const float sa0 = red8(d0[0] + d0[1]), sa1 = red8(d1[0] + d1[1]);
            const f32x2 sa0v = (f32x2){sa0, sa0}, sa1v = (f32x2){sa1, sa1}, v0v = (f32x2){v0, v0}, v1v = (f32x2){v1, v1};
            if (urow) {
#pragma unroll
                for (int c = 0; c < 4; ++c) {
                    S0[c] = S0[c] * w2[c] + (sa0v * b2[c] + v0v * k2[c]);
                    S1[c] = S1[c] * w2[c] + (sa1v * b2[c] + v1v * k2[c]);
                }
            } else {
#pragma unroll
                for (int c = 0; c < 4; ++c) {
                    S0[c] = S0[c] * w2[c] + sa0v * b2[c];
                    S1[c] = S1[c] * w2[c] + sa1v * b2[c];
                }
            }
        }
        __syncthreads();
    }
    float* dst = PU + ((size_t)(bh * NCH + ch) * 128 + 2 * rp) * 64 + cb * 8;
    *(f32x4*)(dst) = (f32x4){S0[0][0], S0[0][1], S0[1][0], S0[1][1]}; *(f32x4*)(dst + 4) = (f32x4){S0[2][0], S0[2][1], S0[3][0], S0[3][1]};
    *(f32x4*)(dst + 64) = (f32x4){S1[0][0], S1[0][1], S1[1][0], S1[1][1]}; *(f32x4*)(dst + 68) = (f32x4){S1[2][0], S1[2][1], S1[3][0], S1[3][1]};
}

typedef float f32x16 __attribute__((ext_vector_type(16)));
__device__ __forceinline__ float swap_sum32(float x) { const auto rr = __builtin_amdgcn_permlane32_swap(__float_as_uint(x), __float_as_uint(x), false, false); return __uint_as_float(rr[0]) + __uint_as_float(rr[1]); }
constexpr int SUBM = 32;
__device__ __forceinline__ void scan_pass1_pair(const Params& p, const bf16_t* P, float* PU, float* ldsf, int pair) {
    const int tid = otid(), ug = tid >> 8, utid = tid & 255, lane = tid & 63, wq = utid >> 6, l31 = lane & 31, hi = lane >> 5;
    const int unit = pair * 2 + ug;
    const int bh = unit / (NCH - 1), ch = unit % (NCH - 1), b = bh >> 4, h = bh & 15;
    float* st = ldsf + ug * (5 * SUBM * 64 + 512); float* cst = st + 5 * SUBM * 64;
    const int R = wq * 32 + l31;
    const bool urow = wq < 2;
    const int irow = R & 63;
    f32x16 T0, T1;
#pragma unroll
    for (int r = 0; r < 16; ++r) { const int j0 = 8 * (r >> 2) + 4 * hi + (r & 3); T0[r] = (!urow && j0 == irow) ? 1.f : 0.f; T1[r] = (!urow && 32 + j0 == irow) ? 1.f : 0.f; }
    const int rowbase = b * SEQ + ch * CHUNK;
    const int ptt = utid >> 3, pcb = utid & 7;
    load_cst(p, cst, h, utid); load_cst(p, cst, h, utid + 256);
    PrepRegs Rg; prep_issue(Rg, p, P, rowbase + ptt, h, pcb);
    __syncthreads();
    for (int sc = 0; sc < CHUNK / SUBM; ++sc) {
        prep_finish_norm<SUBM, false>(Rg, st, cst, ptt, pcb, ((rowbase + sc * SUBM + ptt) & (SEQ - 1)) == 0, h, lane, wq);
        __syncthreads();
        if (sc + 1 < CHUNK / SUBM) prep_issue(Rg, p, P, rowbase + (sc + 1) * SUBM + ptt, h, pcb);
#pragma unroll 2
        for (int tt = 0; tt < SUBM; ++tt) {
            const float* sA = st + (1 * SUBM + tt) * 64 + 4 * hi;
            f32x16 a0, a1;
#pragma unroll
            for (int q = 0; q < 4; ++q) {
                const f32x4 xa0 = *(const f32x4*)(sA + 8 * q), xa1 = *(const f32x4*)(sA + 32 + 8 * q);
#pragma unroll
                for (int e = 0; e < 4; ++e) { a0[4 * q + e] = xa0[e]; a1[4 * q + e] = xa1[e]; }
            }
            const float areg0 = st[((2 + hi) * SUBM + tt) * 64 + l31], areg1 = st[((2 + hi) * SUBM + tt) * 64 + 32 + l31];
            const float vi = st[(4 * SUBM + tt) * 64 + irow];
            const f32x16 pr = T0 * a0 + T1 * a1;
            const float s01 = ((pr[0] + pr[1]) + (pr[2] + pr[3])) + ((pr[4] + pr[5]) + (pr[6] + pr[7]));
            const float s23 = ((pr[8] + pr[9]) + (pr[10] + pr[11])) + ((pr[12] + pr[13]) + (pr[14] + pr[15]));
            const float sa = swap_sum32(s01 + s23);
            const float breg = hi ? (urow ? vi : 0.f) : sa;
            T0 = __builtin_amdgcn_mfma_f32_32x32x2f32(areg0, breg, T0, 0, 0, 0);
            T1 = __builtin_amdgcn_mfma_f32_32x32x2f32(areg1, breg, T1, 0, 0, 0);
        }
#pragma unroll
        for (int q = 0; q < 4; ++q) {
            const f32x4 g0 = *(const f32x4*)(st + 256 + 8 * q + 4 * hi), g1 = *(const f32x4*)(st + 256 + 32 + 8 * q + 4 * hi);
#pragma unroll
            for (int e = 0; e < 4; ++e) { T0[4 * q + e] *= g0[e]; T1[4 * q + e] *= g1[e]; }
        }
        __syncthreads();
    }
    float* dst = PU + ((size_t)(bh * NCH + ch) * 128 + R) * 64 + 4 * hi;
#pragma unroll
    for (int q = 0; q < 4; ++q) {
        *(f32x4*)(dst + 8 * q) = (f32x4){T0[4 * q], T0[4 * q + 1], T0[4 * q + 2], T0[4 * q + 3]};
        *(f32x4*)(dst + 32 + 8 * q) = (f32x4){T1[4 * q], T1[4 * q + 1], T1[4 * q + 2], T1[4 * q + 3]};
    }
}

__device__ __forceinline__ void scan_pass2_wave(const float* PU, float* SC, int wu, int lane) {
    const int bh = wu >> 6, i = wu & 63;
    float S = 0.f;
    float pc[64], uc;
    { const float* Uc = PU + (size_t)(bh * NCH) * 128 * 64; uc = Uc[i * 64 + lane];
#pragma unroll
      for (int m = 0; m < 64; ++m) pc[m] = Uc[64 * 64 + m * 64 + lane]; }
#pragma unroll 1
    for (int c = 0; c < NCH - 1; ++c) {
        float pn[64], un = 0.f;
        const int cn = (c + 1 < NCH - 1) ? c + 1 : c;
        { const float* Un = PU + (size_t)(bh * NCH + cn) * 128 * 64; un = Un[i * 64 + lane];
#pragma unroll
          for (int m = 0; m < 64; ++m) pn[m] = Un[64 * 64 + m * 64 + lane]; }
        float acc = uc, acc2 = 0.f;
#pragma unroll
        for (int m = 0; m < 64; m += 2) {
            acc += __int_as_float(__builtin_amdgcn_readlane(__float_as_int(S), m)) * pc[m];
            acc2 += __int_as_float(__builtin_amdgcn_readlane(__float_as_int(S), m + 1)) * pc[m + 1];
        }
        S = acc + acc2;
        SC[(size_t)(bh * NCH + c + 1) * 4096 + i * 64 + lane] = S;
        uc = un;
#pragma unroll
        for (int m = 0; m < 64; ++m) pc[m] = pn[m];
    }
}

template <bool IS_S>
__device__ __forceinline__ void scan_pass3_pair(const Params& p, const bf16_t* P, const float* SC, bf16_t* rwkv_o, float* ldsf, int pair) {
    const int tid = otid(), ug = tid >> 8, utid = tid & 255;
    const int unit = pair * 2 + ug;
    int h, row_base; const float* Sinit; float* Sfinal; const float* sprev = nullptr;
    constexpr int ntok = IS_S ? 1 : CHUNK;
    if (!IS_S) { const int bh = unit / NCH, ch = unit % NCH; h = bh & 15; row_base = (bh >> 4) * SEQ + ch * CHUNK;
        Sinit = ch ? SC + (size_t)(bh * NCH + ch) * 4096 : nullptr; Sfinal = (ch == NCH - 1) ? p.out + O_WKVP + (size_t)bh * 4096 : nullptr; }
    else { h = unit & 15; row_base = MP + (unit >> 4); Sinit = p.in[5] + (size_t)unit * 4096; Sfinal = p.out + O_WKVS + (size_t)unit * 4096; sprev = p.in[4] + (size_t)(unit >> 4) * RW; }
    float* st = ldsf + ug * (7 * SUB3 * 64 + 512); float* yb = st + 6 * SUB3 * 64; float* cst = yb + SUB3 * 64;
    const int rp = utid >> 3, cb = utid & 7;
    f32x2 S0[4], S1[4];
    if (Sinit) { const float* s = Sinit + (2 * rp) * 64 + cb * 8;
        const f32x4 a = *(const f32x4*)s, bq = *(const f32x4*)(s + 4), c = *(const f32x4*)(s + 64), d = *(const f32x4*)(s + 68);
        S0[0] = (f32x2){a[0], a[1]}; S0[1] = (f32x2){a[2], a[3]}; S0[2] = (f32x2){bq[0], bq[1]}; S0[3] = (f32x2){bq[2], bq[3]};
        S1[0] = (f32x2){c[0], c[1]}; S1[1] = (f32x2){c[2], c[3]}; S1[2] = (f32x2){d[0], d[1]}; S1[3] = (f32x2){d[2], d[3]}; }
    else {
#pragma unroll
        for (int c = 0; c < 4; ++c) { S0[c] = (f32x2){0.f, 0.f}; S1[c] = (f32x2){0.f, 0.f}; } }
    load_cst(p, cst, h, utid); load_cst(p, cst, h, utid + 256);
    constexpr int nsub = (ntok + SUB3 - 1) / SUB3;
    PrepRegs R;
    if (rp < ntok) prep_issue(R, p, P, row_base + rp, h, cb);
    __syncthreads();
    for (int sc = 0; sc < nsub; ++sc) {
        constexpr int nv = IS_S ? 1 : SUB3;
        const int row0 = row_base + sc * SUB3;
        prep_finish_norm<SUB3, true>(R, st, cst, rp, cb, ((row0 + rp) & (SEQ - 1)) == 0, h, tid & 63, utid >> 6);
        __syncthreads();
        u32x4 greg = (u32x4){0u, 0u, 0u, 0u};
        if (rp < nv) greg = *(const u32x4*)((const unsigned char*)p.out + (size_t)(row0 + rp) * 8192 + 6144 + (size_t)(h * 64 + cb * 8) * 2);
        if (!IS_S && sc + 1 < nsub) prep_issue(R, p, P, row0 + SUB3 + rp, h, cb);
#pragma unroll 2
        for (int tt = 0; tt < nv; ++tt) {
            f32x2 a2[4], b2[4], k2[4], r2[4];
            LD8S(a2, 1, SUB3); LD8S(b2, 2, SUB3); LD8S(k2, 3, SUB3); LD8S(r2, 5, SUB3);
            const f32x2 vv = *(const f32x2*)(st + (4 * SUB3 + tt) * 64 + 2 * rp);
            f32x2 d0 = S0[0] * a2[0], d1 = S1[0] * a2[0];
#pragma unroll
            for (int c = 1; c < 4; ++c) { d0 += S0[c] * a2[c]; d1 += S1[c] * a2[c]; }
            const float sa0 = red8(d0[0] + d0[1]), sa1 = red8(d1[0] + d1[1]);
            const f32x2 sa0v = (f32x2){sa0, sa0}, sa1v = (f32x2){sa1, sa1}, v0v = (f32x2){vv[0], vv[0]}, v1v = (f32x2){vv[1], vv[1]};
#pragma unroll
            for (int c = 0; c < 4; ++c) {
                S0[c] = S0[c] + (sa0v * b2[c] + v0v * k2[c]);
                S1[c] = S1[c] + (sa1v * b2[c] + v1v * k2[c]);
            }
            f32x2 y0 = S0[0] * r2[0], y1 = S1[0] * r2[0];
#pragma unroll
            for (int c = 1; c < 4; ++c) { y0 += S0[c] * r2[c]; y1 += S1[c] * r2[c]; }
            const float ys0 = red8(y0[0] + y0[1]), ys1 = red8(y1[0] + y1[1]);
            if (cb == 0) *(f32x2*)(yb + tt * 64 + 2 * rp) = (f32x2){ys0, ys1};
        }
        { const f32x4 g0 = *(const f32x4*)(st + 256 + cb * 8), g1 = *(const f32x4*)(st + 256 + cb * 8 + 4);
          const f32x2 ga = (f32x2){g0[0], g0[1]}, gb = (f32x2){g0[2], g0[3]}, gc = (f32x2){g1[0], g1[1]}, gd = (f32x2){g1[2], g1[3]};
          S0[0] *= ga; S0[1] *= gb; S0[2] *= gc; S0[3] *= gd; S1[0] *= ga; S1[1] *= gb; S1[2] *= gc; S1[3] *= gd; }
        __syncthreads();
        if (rp < nv) {
            const int tt = rp;
            const f32x4 ya = *(const f32x4*)(yb + tt * 64 + cb * 8), yb4 = *(const f32x4*)(yb + tt * 64 + cb * 8 + 4);
            const float y[8] = {ya[0], ya[1], ya[2], ya[3], yb4[0], yb4[1], yb4[2], yb4[3]};
            float s = 0.f;
#pragma unroll
            for (int i = 0; i < 8; ++i) s += y[i];
            const float mean = red8(s) * (1.f / 64.f);
            float q = 0.f;
#pragma unroll
            for (int i = 0; i < 8; ++i) { const float dd = y[i] - mean; q += dd * dd; }
            const float rstd = rsqrtf(red8(q) * (1.f / 64.f) + GN_EPS);
            const float* sr = st + (5 * SUB3 + tt) * 64 + cb * 8; const float* sk = st + (3 * SUB3 + tt) * 64 + cb * 8; const float* sv = st + (4 * SUB3 + tt) * 64 + cb * 8;
            const float* c5 = cst + 5 * 64 + cb * 8;
            float rkp = 0.f; float vs[8], gw[8], gb[8];
#pragma unroll
            for (int i = 0; i < 8; i += 4) { const f32x4 r4 = *(const f32x4*)(sr + i), k4 = *(const f32x4*)(sk + i), v4 = *(const f32x4*)(sv + i), c4 = *(const f32x4*)(c5 + i), w4 = *(const f32x4*)(c5 + 64 + i), b4 = *(const f32x4*)(c5 + 128 + i);
#pragma unroll
                for (int j = 0; j < 4; ++j) { rkp += r4[j] * k4[j] * c4[j]; vs[i + j] = v4[j]; gw[i + j] = w4[j]; gb[i + j] = b4[j]; } }
            const float rk = red8(rkp);
            float g[8]; unpack8(greg, g);
            float o[8];
#pragma unroll
            for (int i = 0; i < 8; ++i) o[i] = ((y[i] - mean) * rstd * gw[i] + gb[i] + rk * vs[i]) * g[i];
            u32x4 ow; ow.x = pk2(o[0], o[1]); ow.y = pk2(o[2], o[3]); ow.z = pk2(o[4], o[5]); ow.w = pk2(o[6], o[7]);
            *(u32x4*)(rwkv_o + (size_t)(row0 + tt) * AW + h * 64 + cb * 8) = ow;
        }
        __syncthreads();
    }
    if (Sfinal) { float* dst = Sfinal + (2 * rp) * 64 + cb * 8;
        *(f32x4*)(dst) = (f32x4){S0[0][0], S0[0][1], S0[1][0], S0[1][1]}; *(f32x4*)(dst + 4) = (f32x4){S0[2][0], S0[2][1], S0[3][0], S0[3][1]};
        *(f32x4*)(dst + 64) = (f32x4){S1[0][0], S1[0][1], S1[1][0], S1[1][1]}; *(f32x4*)(dst + 68) = (f32x4){S1[2][0], S1[2][1], S1[3][0], S1[3][1]}; }
}

__device__ __forceinline__ void sample_scan_wave(const Params& p, const bf16_t* P, bf16_t* rwkv_o, int wu, int lane) {
    const int b = wu >> 4, h = wu & 15, hj = h * 64 + lane, row = MP + b;
    const bf16_t* q = P + (size_t)row * LDP;
    const float* sp = p.in[4] + (size_t)b * RW;
    const float* mu = p.in[8];
    const float cr = bf2f(q[COL_R + hj]), ck = bf2f(q[COL_RK + hj]), cv = bf2f(q[COL_RV + hj]);
    const float rs = cr + (sp[hj] - cr) * mu[hj], ks = ck + (sp[1024 + hj] - ck) * mu[1024 + hj], vs = cv + (sp[2048 + hj] - cv) * mu[2048 + hj];
    const unsigned char* lw = (const unsigned char*)p.out + (size_t)row * 8192;
    const float w = ((const float*)lw)[hj];
    const float a = bf2f(((const bf16_t*)(lw + 4096))[hj]), g = bf2f(((const bf16_t*)(lw + 6144))[hj]);
    const float* Sin = p.in[5] + (size_t)wu * 4096 + lane * 64;
    float S[64];
#pragma unroll
    for (int c = 0; c < 64; c += 4) { const f32x4 t = *(const f32x4*)(Sin + c); S[c] = t[0]; S[c + 1] = t[1]; S[c + 2] = t[2]; S[c + 3] = t[3]; }
    const float kr = ks * p.in[14][hj];
    const float ss = wave_sum(kr * kr);
    const float kk = kr / fmaxf(sqrtf(ss), 1e-12f);
    const float na = -kk, bb = kk * a, kp = ks * (1.f + (a - 1.f) * p.in[15][hj]);
#define BC(x, c) __int_as_float(__builtin_amdgcn_readlane(__float_as_int(x), (c)))
    float sa0 = 0.f, sa1 = 0.f;
#pragma unroll
    for (int c = 0; c < 64; c += 2) { sa0 += S[c] * BC(na, c); sa1 += S[c + 1] * BC(na, c + 1); }
    const float sa = sa0 + sa1;
    float y0 = 0.f, y1 = 0.f;
#pragma unroll
    for (int c = 0; c < 64; c += 2) {
        S[c] = S[c] * BC(w, c) + (sa * BC(bb, c) + vs * BC(kp, c));
        S[c + 1] = S[c + 1] * BC(w, c + 1) + (sa * BC(bb, c + 1) + vs * BC(kp, c + 1));
        y0 += S[c] * BC(rs, c); y1 += S[c + 1] * BC(rs, c + 1);
    }
#undef BC
    const float y = y0 + y1;
    float* Sout = p.out + O_WKVS + (size_t)wu * 4096 + lane * 64;
#pragma unroll
    for (int c = 0; c < 64; c += 4) *(f32x4*)(Sout + c) = (f32x4){S[c], S[c + 1], S[c + 2], S[c + 3]};
    const float mean = wave_sum(y) * (1.f / 64.f);
    const float dy = y - mean;
    const float var = wave_sum(dy * dy) * (1.f / 64.f);
    const float rk = wave_sum(rs * kp * p.in[16][hj]);
    const float o = (dy * rsqrtf(var + GN_EPS) * p.in[17][hj] + p.in[18][hj] + rk * vs) * g;
    rwkv_o[(size_t)row * AW + hj] = (bf16_t)(pk2(o, 0.f) & 0xffffu);
}

__device__ __forceinline__ void ln_rows(bf16_t* zb, int ldz, const float* g, const float* bt, float* OUTF, int gw, int ngw, int lane) {
    for (int row = gw; row < MREAL; row += ngw) {
        bf16_t* zr = zb + (size_t)row * ldz + lane * 4;
        f32x4 v[8]; float s = 0.f;
#pragma unroll
        for (int j = 0; j < 8; ++j) { const u32x2 w = *(const u32x2*)(zr + j * 256); v[j] = (f32x4){bflo(w.x), bfhi(w.x), bflo(w.y), bfhi(w.y)}; s += (v[j][0] + v[j][1]) + (v[j][2] + v[j][3]); }
        const float mean = wave_sum(s) * (1.f / DM); float s2 = 0.f;
#pragma unroll
        for (int j = 0; j < 8; ++j) { v[j] = v[j] - mean; s2 += (v[j][0] * v[j][0] + v[j][1] * v[j][1]) + (v[j][2] * v[j][2] + v[j][3] * v[j][3]); }
        const float rstd = rsqrtf(wave_sum(s2) * (1.f / DM) + LN_EPS);
#pragma unroll
        for (int j = 0; j < 8; ++j) {
            const f32x4 gv = *(const f32x4*)(g + j * 256 + lane * 4), bv = *(const f32x4*)(bt + j * 256 + lane * 4);
            const f32x4 o = v[j] * rstd * gv + bv;
            if (OUTF) *(f32x4*)(OUTF + (size_t)row * DM + j * 256 + lane * 4) = o;
            else { u32x2 w; w.x = pk2(o[0], o[1]); w.y = pk2(o[2], o[3]); *(u32x2*)(zr + j * 256) = w; }
        }
    }
}

#define XB_TMO      128
#define XB_XCNT(j)  (256  + 64 * (j))
#define XB_XSUB(j)  (1280 + 64 * (j))
#define XB_XGEN(j)  (2304 + 64 * (j))
#define XB_TOP      3328
#define XB_TOPGEN   3392
#define XCD_BAR_WORDS 3456
#define XB_SPIN_CAP (1u << 18)

__device__ __forceinline__ unsigned xb_ld(unsigned* p)              { return __hip_atomic_load(p, __ATOMIC_RELAXED, __HIP_MEMORY_SCOPE_AGENT); }
__device__ __forceinline__ unsigned xb_add(unsigned* p, unsigned v) { return __hip_atomic_fetch_add(p, v, __ATOMIC_RELAXED, __HIP_MEMORY_SCOPE_AGENT); }
__device__ __forceinline__ unsigned xb_xcc_id() { return (unsigned)__builtin_amdgcn_s_getreg((3 << 11) | 20) & 0xFu; }
#define XB_SPIN(cond, bar) do { unsigned _sp = 0; while (cond) { __builtin_amdgcn_s_sleep(1); \
    if ((++_sp & 255u) == 0u) { if (xb_ld(&(bar)[XB_TMO])) break; if (_sp > XB_SPIN_CAP) { atomicAdd(&(bar)[XB_TMO], 1u); break; } } } } while (0)

struct XcdBarrier {
    unsigned* bar; unsigned x;
    volatile PG8_LAS unsigned* st;
};

__device__ __forceinline__ XcdBarrier xcd_barrier_post(unsigned* bar, volatile PG8_LAS unsigned* st) {
    XcdBarrier b; b.bar = bar; b.x = xb_xcc_id(); b.st = st;
    if (threadIdx.x == 0) (void)xb_add(&bar[XB_XCNT(b.x)], 1u);
    return b;
}
__device__ __forceinline__ void xcd_barrier_complete(unsigned* bar, unsigned x, unsigned& nloc, unsigned& nx) {
    const unsigned G = gridDim.x * gridDim.y * gridDim.z;
    unsigned sum, cnt, mine, sp = 0u;
    for (;;) {
        sum = 0u; cnt = 0u; mine = 0u;
#pragma unroll
        for (unsigned j = 0; j < 16; ++j) { const unsigned c = xb_ld(&bar[XB_XCNT(j)]); sum += c; cnt += (c > 0u) ? 1u : 0u; mine = (j == x) ? c : mine; }
        if (sum == G) break;
        __builtin_amdgcn_s_sleep(1);
        if ((++sp & 255u) == 0u) { if (xb_ld(&bar[XB_TMO])) break; if (sp > XB_SPIN_CAP) { atomicAdd(&bar[XB_TMO], 1u); break; } }
    }
    nloc = mine > 0u ? mine : 1u; nx = cnt > 0u ? cnt : 1u;
}

__device__ __forceinline__ void xcd_barrier(const XcdBarrier& b) {
    asm volatile("s_waitcnt vmcnt(0)" ::: "memory");
    __syncthreads();
    if (threadIdx.x == 0) {
        unsigned* bar = b.bar;
        __builtin_amdgcn_s_waitcnt(0);
        unsigned nloc = b.st[0], nx = b.st[1];
        if (nloc == 0u) { xcd_barrier_complete(bar, b.x, nloc, nx); b.st[0] = nloc; b.st[1] = nx; }
        const unsigned old = xb_add(&bar[XB_XSUB(b.x)], 1u);
        const unsigned gen = old / nloc;
        if (old + 1u == (gen + 1u) * nloc) {
            __builtin_amdgcn_fence(__ATOMIC_RELEASE, "agent");
            asm volatile("s_waitcnt vmcnt(0)" ::: "memory");
            const unsigned og = xb_add(&bar[XB_TOP], 1u);
            const unsigned tg = og / nx;
            if (og + 1u == (tg + 1u) * nx) xb_add(&bar[XB_TOPGEN], 1u);
            else XB_SPIN(xb_ld(&bar[XB_TOPGEN]) == tg, bar);
            __builtin_amdgcn_fence(__ATOMIC_ACQUIRE, "agent");
            xb_add(&bar[XB_XGEN(b.x)], 1u);
            asm volatile("s_waitcnt vmcnt(0)" ::: "memory");
        } else {
            XB_SPIN(xb_ld(&bar[XB_XGEN(b.x)]) == gen, bar);
            __builtin_amdgcn_fence(__ATOMIC_ACQUIRE, "agent");
            asm volatile("s_waitcnt vmcnt(0)" ::: "memory");
        }
    }
    __syncthreads();
}

__device__ __forceinline__ void gsync(unsigned* flags, unsigned& gen) {
    asm volatile("s_waitcnt vmcnt(0) lgkmcnt(0)" ::: "memory");
    __syncthreads();
    gen += 1u;
    const unsigned tagk = 0x5EED0000u + gen;
    if (threadIdx.x == 0) {
        __builtin_amdgcn_fence(__ATOMIC_RELEASE, "agent");
        asm volatile("s_waitcnt vmcnt(0)" ::: "memory");
        __hip_atomic_store(flags + 32 * blockIdx.x, tagk, __ATOMIC_RELAXED, __HIP_MEMORY_SCOPE_AGENT);
    }
    if (threadIdx.x < gridDim.x) {
        unsigned* f = flags + 32 * threadIdx.x;
        for (;;) { const unsigned v = __hip_atomic_load(f, __ATOMIC_RELAXED, __HIP_MEMORY_SCOPE_AGENT); if (v == tagk || v == tagk + 1u) break; __builtin_amdgcn_s_sleep(2); }
    }
    __syncthreads();
    __builtin_amdgcn_fence(__ATOMIC_ACQUIRE, "agent");
    asm volatile("s_waitcnt vmcnt(0) lgkmcnt(0)" ::: "memory");
}

#ifndef PROBE_AT
#define PROBE_AT 0
#endif
__device__ __forceinline__ void probe_dump(const Params& p, const bf16_t* a, size_t na, const bf16_t* b, size_t nb) {
    const size_t gt = (size_t)blockIdx.x * NTHREADS + threadIdx.x, NGT = (size_t)gridDim.x * NTHREADS;
    for (size_t e = gt; e < O_END; e += NGT) {
        float v = 0.f;
        if (e < na) v = bf2f(a[e]); else if (e < na + nb) v = bf2f(b[e - na]);
        p.out[e] = v;
    }
}
__global__ void __launch_bounds__(NTHREADS, 2) mega_fwd(Params p) {
    extern __shared__ __attribute__((aligned(16))) unsigned char lds[];
    cg::grid_group grid = cg::this_grid();
    const int G = gridDim.x;
    unsigned char* ws = p.ws;
    bf16_t* Pm = (bf16_t*)(ws + WS_P);
    bf16_t* regA = (bf16_t*)(ws + WS_A);
    bf16_t* rwkv_o = (bf16_t*)(ws + WS_RWO);
    float* PU = (float*)(ws + WS_PU);
    float* SC = (float*)(ws + WS_SC);
    PG8_LAS unsigned char* ldsl = (PG8_LAS unsigned char*)lds;
    float* part = (float*)(ws + WS_PB); unsigned* cnt = (unsigned*)ws; PG8_LAS unsigned* tflag = (PG8_LAS unsigned*)(ldsl + 131072);

    unsigned* bar = (unsigned*)ws + 1024; unsigned gen = 0u;
    unsigned* xbar = (unsigned*)ws + 16384; volatile PG8_LAS unsigned* xst = (volatile PG8_LAS unsigned*)((PG8_LAS unsigned char*)lds + 131072 + 64);
    if (threadIdx.x == 0) { xst[0] = 0u; xst[1] = 0u; }
    __syncthreads();
    grid.sync();
    REP(0) { if (blockIdx.x == 0) { cnt[threadIdx.x] = 0u; for (int i = threadIdx.x; i < XCD_BAR_WORDS; i += NTHREADS) xbar[i] = 0u; }
    phase0(p, lds);
    gsync(bar, gen); }
    XcdBarrier xb = xcd_barrier_post(xbar, xst);
    REP(1) {
        pg8::Gemm g{regA, (const bf16_t*)(ws + WS_WIN), MP, LDP, DM, DM, DM};
        pg8::StaticOrder S; S.init(MP, LDP, G, (int)blockIdx.x);
        pg8::EpiP E{Pm};
        pg8::gemm_phase<pg8::EpiP, pg8::StaticOrder, true, true>(ldsl, g, S, E);
        pg8::Gemm gt{regA, (const bf16_t*)(ws + WS_WIN), MPAD, LDP, 512, DM, DM};
        pg8::TailOrder T{LDP / 256, 4, 4, G, (int)blockIdx.x, MP / 256, 1024, 1024, 0, 0};
        pg8::EpiTail<true, 0, 4> ET{{part, cnt + 0, LDP, 4, tflag, Pm, nullptr, nullptr, 0, nullptr}};
        pg8::gemm_phase<pg8::EpiTail<true, 0, 4>, pg8::TailOrder, true, true>(ldsl, gt, T, ET);
    xcd_barrier(xb); }
    REP(2) { phase2(p, lds);
    xcd_barrier(xb); }
#if PROBE_AT == 2
    { const size_t gt = (size_t)blockIdx.x * NTHREADS + threadIdx.x, NGT = (size_t)gridDim.x * NTHREADS; for (size_t e = gt; e < (size_t)MREAL * 2048; e += NGT) { const unsigned w = __float_as_uint(p.out[e]); p.out[e] = (float)(w & 0xffffu) * 1e-3f + (float)(w >> 16) * 1e-3f + bf2f(regA[e >> 1]); } } return;
#endif
    REP(3) { for (int pr = blockIdx.x; pr < 16 * (NCH - 1); pr += G) scan_pass1_pair(p, Pm, PU, (float*)lds, pr);
    xcd_barrier(xb); }
    REP(4) { const int t4 = otid(); for (int wu = blockIdx.x * 8 + (t4 >> 6); wu < 32 * 64; wu += G * 8) scan_pass2_wave(PU, SC, wu, t4 & 63);
    for (int su = blockIdx.x * 8 + (t4 >> 6); su < MS * 16; su += G * 8) sample_scan_wave(p, Pm, rwkv_o, su, t4 & 63);
    xcd_barrier(xb); }
    REP(5) { for (int pr = blockIdx.x; pr < 32 * NCH / 2; pr += G) scan_pass3_pair<false>(p, Pm, SC, rwkv_o, (float*)lds, pr);
    xcd_barrier(xb); }
#if PROBE_AT == 5
    probe_dump(p, regA, (size_t)MREAL * AW, rwkv_o, (size_t)MREAL * AW); return;
#endif
    {
        pg8::StaticOrder S; S.init(MP, DM, G, (int)blockIdx.x, 8);
        { pg8::Gemm g{regA, (const bf16_t*)(ws + WS_WPA), MP, DM, AW, AW, AW};
          pg8::EpiGateA E{Pm, p.out};
          pg8::gemm_phase<pg8::EpiGateA, pg8::StaticOrder, true, true>(ldsl, g, S, E); }
        __threadfence();
        { pg8::Gemm g{rwkv_o, (const bf16_t*)(ws + WS_WPR), MP, DM, AW, AW, AW};
          pg8::EpiGateB E{Pm, p.out};
          pg8::gemm_phase<pg8::EpiGateB, pg8::StaticOrder, true, true>(ldsl, g, S, E);
          pg8::Gemm gt{regA, (const bf16_t*)(ws + WS_WPA), MPAD, DM, 256, AW, AW};
          pg8::TailOrder T{DM / 256, 4, 8, G, (int)blockIdx.x, MP / 256, 512, 512, (long)MPAD * AW * 2, (long)(WS_WPR - WS_WPA)};
          pg8::EpiTail<false, 1, 4> ET{{part, cnt + 64, DM, 8, tflag, Pm, nullptr, nullptr, 0, nullptr}};
          pg8::gemm_phase<pg8::EpiTail<false, 1, 4>, pg8::TailOrder, true, true>(ldsl, gt, T, ET); }
    }
    xcd_barrier(xb);
    REP(7) {
        pg8::Gemm g{Pm + COL_GA, (const bf16_t*)(ws + WS_WOUT), MP, DM, DM, LDP, DM};
        pg8::StaticOrder S; S.init(MP, DM, G, (int)blockIdx.x);
        pg8::EpiResid E{p.in[0], p.in[1], regA, DM, nullptr};
        pg8::gemm_phase<pg8::EpiResid, pg8::StaticOrder, true, true>(ldsl, g, S, E);
        pg8::Gemm gt{Pm + COL_GA, (const bf16_t*)(ws + WS_WOUT), MPAD, DM, 256, LDP, DM};
        pg8::TailOrder T{DM / 256, 8, 8, G, (int)blockIdx.x, MP / 256, 512, 512, 0, 0};
        pg8::EpiTail<false, 2, 8> ET{{part, cnt + 128, DM, 8, tflag, Pm, p.in[1], regA, DM, nullptr}};
        pg8::gemm_phase<pg8::EpiTail<false, 2, 8>, pg8::TailOrder, true, true>(ldsl, gt, T, ET);
    xcd_barrier(xb); }
    { const int t8 = otid(); ln_rows(regA, DM, p.in[22], p.in[23], nullptr, blockIdx.x * 8 + (t8 >> 6), G * 8, t8 & 63); }
    xcd_barrier(xb);
    REP(9) {
        pg8::Gemm g{regA, (const bf16_t*)(ws + WS_WUP), MP, DFF, DM, DM, DM};
        pg8::StaticOrder S; S.init(MP, DFF, G, (int)blockIdx.x);
        pg8::EpiUp E{Pm};
        pg8::gemm_phase<pg8::EpiUp, pg8::StaticOrder, true, true>(ldsl, g, S, E);
        pg8::Gemm gt{regA, (const bf16_t*)(ws + WS_WUP), MPAD, DFF, 512, DM, DM};
        pg8::TailOrder T{DFF / 256, 4, 4, G, (int)blockIdx.x, MP / 256, 1024, 1024, 0, 0};
        pg8::EpiTail<true, 3, 4> ET{{part, cnt + 192, DFF, 4, tflag, Pm, nullptr, nullptr, 0, nullptr}};
        pg8::gemm_phase<pg8::EpiTail<true, 3, 4>, pg8::TailOrder, true, true>(ldsl, gt, T, ET);
    xcd_barrier(xb); }
    {
        pg8::Gemm g{Pm, (const bf16_t*)(ws + WS_WDN), MP, DM, DFF, DFF, DFF};
        pg8::StaticOrder S; S.init(MP, DM, G, (int)blockIdx.x);
        pg8::EpiResid E{nullptr, nullptr, (bf16_t*)p.out, 2 * DM, regA};
        pg8::gemm_phase<pg8::EpiResid, pg8::StaticOrder, true, true>(ldsl, g, S, E);
        pg8::Gemm gt{Pm, (const bf16_t*)(ws + WS_WDN), MPAD, DM, 512, DFF, DFF};
        pg8::TailOrder T{DM / 256, 16, 16, G, (int)blockIdx.x, MP / 256, 1024, 1024, 0, 0};
        pg8::EpiTail<false, 2, 16> ET{{part, cnt + 256, DM, 16, tflag, Pm, nullptr, (bf16_t*)p.out, 2 * DM, regA}};
        pg8::gemm_phase<pg8::EpiTail<false, 2, 16>, pg8::TailOrder, true, true>(ldsl, gt, T, ET);
    }
    xcd_barrier(xb);
    { const int t11 = otid(); ln_rows((bf16_t*)p.out, 2 * DM, p.in[26], p.in[27], p.out, blockIdx.x * 8 + (t11 >> 6), G * 8, t11 & 63); }
}

extern "C" void kernel_launch(void* const* d_in, const int* in_sizes, int n_in, void* d_out, int out_size, void* d_ws, size_t ws_size, hipStream_t stream) {
    static int grid = 0;
    if (grid == 0) {
        if (n_in != 28 || out_size != (int)O_END || ws_size < WS_END) { fprintf(stderr, "kernel_launch: unexpected shapes: n_in %d out %d ws %zu\n", n_in, out_size, ws_size); grid = -1; return; }
        int dev = 0, cus = 0, per_cu = 0;
        hipGetDevice(&dev);
        hipDeviceGetAttribute(&cus, hipDeviceAttributeMultiprocessorCount, dev);
        hipFuncSetAttribute((const void*)mega_fwd, hipFuncAttributeMaxDynamicSharedMemorySize, LDS_BYTES);
        hipOccupancyMaxActiveBlocksPerMultiprocessor(&per_cu, (const void*)mega_fwd, NTHREADS, LDS_BYTES);
        (void)hipGetLastError();
        if (per_cu < 1) per_cu = 1;
        grid = cus;
        if (grid <= 0) grid = 256;
    }
    if (grid < 0) return;
    Params prm{};
    for (int i = 0; i < 28; ++i) prm.in[i] = (const float*)d_in[i];
    prm.out = (float*)d_out; prm.ws = (unsigned char*)d_ws;
    void* args[] = {&prm};
    hipError_t e = hipLaunchCooperativeKernel((const void*)mega_fwd, dim3(grid), dim3(NTHREADS), args, LDS_BYTES, stream);
    if (e != hipSuccess) fprintf(stderr, "cooperative launch failed: %s (grid %d)\n", hipGetErrorString(e), grid);
}
```

```cpp
#include <hip/hip_runtime.h>
#include <hip/hip_cooperative_groups.h>
#include <cstdio>
#include <cstdint>
namespace cg = cooperative_groups;
__device__ __forceinline__ int otid() { int t = threadIdx.x; asm volatile("" : "+v"(t)); return t; }
namespace pg8 {
#define PG8_LAS __attribute__((address_space(3)))
typedef unsigned short bf16_t;
typedef short bf16x8 __attribute__((ext_vector_type(8)));
typedef float f32x4 __attribute__((ext_vector_type(4)));
typedef unsigned u32x4 __attribute__((ext_vector_type(4)));
constexpr int BM = 256, BK = 64, HALF = 128, HTB = HALF * BK * 2  , STAGE_BYTES = 8 * HTB, NXCD = 8, WGM = 4;

__host__ __device__ __forceinline__ int lds_byte(int r, int c) { const int st = (r >> 4) * 2 + (c >> 5), rr = r & 15, cc = c & 31, ob = rr * 64 + cc * 2; return st * 1024 + (ob ^ (((ob >> 9) & 1) << 5)); }
__host__ __device__ __forceinline__ void stage_rc(int b, int& R, int& C) { const int st = b / 1024, sb = b % 1024, swz = sb ^ (((sb >> 9) & 1) << 5); R = (st >> 1) * 16 + swz / 64; C = (st & 1) * 32 + (swz % 64) / 2; }
__host__ __device__ __forceinline__ int perm32(int rho) { const int n = rho >> 4, i = rho & 15; return 8 * (i >> 2) + 4 * n + (i & 3); }

struct Unit { int pm, pn, slot; long offA, offB; };
struct Gemm { const bf16_t* A; const bf16_t* Bt; int M, N, K, lda, ldb; };

struct StaticOrder {
    int nM, nN, nwg, G, c, wgm;
    __host__ __device__ void init(int M, int N, int G_, int c_, int wgm_ = WGM) { nM = M / BM; nN = N / BM; nwg = nM * nN; G = G_; c = c_; wgm = wgm_; }
    __host__ __device__ bool next(int i, Unit& u) const {
        const long L = (long)i * G + c; if (L >= nwg) return false;
        int wgid = (int)L; { const int q = nwg / NXCD, r = nwg % NXCD, xcd = wgid % NXCD, off = wgid / NXCD; wgid = (xcd < r ? xcd * (q + 1) : r * (q + 1) + (xcd - r) * q) + off; }
        const int nig = wgm * nN, gid = wgid / nig, fm = gid * wgm, gsz = (nM - fm) < wgm ? (nM - fm) : wgm;
        u.pm = fm + ((wgid % nig) % gsz); u.pn = (wgid % nig) / gsz; u.slot = 0; u.offA = 0; u.offB = 0; return true;
    }
    __device__ __forceinline__ void a_ready(const Unit&) const {}
    __device__ __forceinline__ void done(const Unit&) const {}
};
template <class Epi, class Sched, bool ALIGN_EPI = false, bool SP2 = false>
__device__ __forceinline__ void gemm_phase(PG8_LAS unsigned char* lds, const Gemm g, const Sched& S, const Epi& E) {
    const int tid = otid(), wid = __builtin_amdgcn_readfirstlane(tid >> 6), lane = tid & 63, wr = wid >> 2, wc = wid & 3, fr = lane & 15, fq = lane >> 4;
    const int K = g.K, nt = K / BK;
    unsigned voffA[2], voffB[2];
#pragma unroll
    for (int i = 0; i < 2; ++i) { int R, C; stage_rc(tid * 16 + i * 8192, R, C); const int Rb = Epi::PERM ? ((R & ~31) + perm32(R & 31)) : R;
        voffA[i] = (unsigned)(R * g.lda + C) * 2u; voffB[i] = (unsigned)(Rb * g.ldb + C) * 2u; }
    const size_t kstep = (size_t)(BK * 2);
    const size_t hstepA = (size_t)HALF * g.lda * 2, hstepB = (size_t)HALF * g.ldb * 2;
    const size_t tstepA = 2 * hstepA, tstepB = 2 * hstepB;
    const unsigned ldsw = (unsigned)wid * 1024u;
    const int aoff = lds_byte(wr * 64 + fr, fq * 8), boff = lds_byte(wc * 32 + fr, fq * 8);
#define PG8_SA(b, h) (((b) * 2 + (h)) * HTB)
#define PG8_SB(b, h) ((4 + (b) * 2 + (h)) * HTB)
#define PG8_STAGE(bufoff, gbase, voff) do { _Pragma("unroll") for (int _i = 0; _i < 2; ++_i) \
        __builtin_amdgcn_global_load_lds((const unsigned*)((const char*)(gbase) + (voff)[_i]), (PG8_LAS unsigned*)(lds + (bufoff) + ldsw + _i * 8192), 16, 0, 0); } while (0)
#define PG8_LDA(dst, b, h) do { _Pragma("unroll") for (int m = 0; m < 4; ++m) _Pragma("unroll") for (int k = 0; k < 2; ++k) dst[m][k] = *(const PG8_LAS bf16x8*)(lds + PG8_SA(b, h) + aoff + m * 2048 + k * 1024); } while (0)
#define PG8_LDB(dst, b, h) do { _Pragma("unroll") for (int n = 0; n < 2; ++n) _Pragma("unroll") for (int k = 0; k < 2; ++k) dst[n][k] = *(const PG8_LAS bf16x8*)(lds + PG8_SB(b, h) + boff + n * 2048 + k * 1024); } while (0)
#define PG8_MMA(ai, bj, At, Bt) do { __builtin_amdgcn_s_setprio(1); _Pragma("unroll") for (int m = 0; m < 4; ++m) _Pragma("unroll") for (int n = 0; n < 2; ++n) _Pragma("unroll") for (int k = 0; k < 2; ++k) \
        acc[ai][bj][m][n] = __builtin_amdgcn_mfma_f32_16x16x32_bf16(Bt[n][k], At[m][k], acc[ai][bj][m][n], 0, 0, 0); __builtin_amdgcn_s_setprio(0); } while (0)
#define PG8_WAIT_V(n) asm volatile("s_waitcnt vmcnt(" #n ")" ::: "memory")
#define PG8_WAIT_L(n) asm volatile("s_waitcnt lgkmcnt(" #n ")" ::: "memory")
#define PG8_BAR __builtin_amdgcn_s_barrier()
#define PG8_SCHED __builtin_amdgcn_sched_barrier(0)
    Unit cur, nxt; int ui = 0;
    if (!S.next(0, cur)) return;
    f32x4 acc[2][2][4][2];
#pragma unroll
    for (int a = 0; a < 2; ++a)
#pragma unroll
        for (int b = 0; b < 2; ++b)
#pragma unroll
            for (int m = 0; m < 4; ++m)
#pragma unroll
                for (int n = 0; n < 2; ++n) acc[a][b][m][n] = (f32x4){0.f, 0.f, 0.f, 0.f};
    bf16x8 At[4][2], B0[2][2], B1[2][2];
    const char* cA = (const char*)g.A + (size_t)cur.pm * tstepA + cur.offA; const char* cB = (const char*)g.Bt + (size_t)cur.pn * tstepB + cur.offB;
    S.a_ready(cur);
    if constexpr (SP2) {
        PG8_STAGE(PG8_SB(0, 0), cB, voffB); PG8_STAGE(PG8_SB(0, 1), cB + hstepB, voffB); PG8_STAGE(PG8_SA(0, 0), cA, voffA); PG8_STAGE(PG8_SA(0, 1), cA + hstepA, voffA);
        if (wr == 1) PG8_BAR;
        PG8_WAIT_V(2); PG8_BAR;
        PG8_STAGE(PG8_SB(1, 0), cB + kstep, voffB); PG8_STAGE(PG8_SA(1, 0), cA + kstep, voffA); PG8_STAGE(PG8_SB(1, 1), cB + hstepB + kstep, voffB);
        PG8_WAIT_V(6); PG8_BAR;
    } else {
        PG8_STAGE(PG8_SB(0, 0), cB, voffB); PG8_STAGE(PG8_SA(0, 0), cA, voffA); PG8_STAGE(PG8_SB(0, 1), cB + hstepB, voffB); PG8_STAGE(PG8_SA(0, 1), cA + hstepA, voffA);
        if (wr == 1) PG8_BAR;
        PG8_WAIT_V(4); PG8_BAR;
        PG8_STAGE(PG8_SB(1, 0), cB + kstep, voffB); PG8_STAGE(PG8_SA(1, 0), cA + kstep, voffA); PG8_STAGE(PG8_SB(1, 1), cB + hstepB + kstep, voffB);
        PG8_WAIT_V(6); PG8_BAR;
    }
    for (;;) {
        const bool has_next = S.next(ui + 1, nxt);
        const char* nA = has_next ? (const char*)g.A + (size_t)nxt.pm * tstepA + nxt.offA : cA; const char* nB = has_next ? (const char*)g.Bt + (size_t)nxt.pn * tstepB + nxt.offB : cB;
        for (int t = 0; t < nt; t += 2) {
            const bool last = (t == nt - 2);
            const char* a1 = cA + (size_t)(t + 1) * kstep;
            const char* a2 = last ? nA : cA + (size_t)(t + 2) * kstep; const char* b2 = last ? nB : cB + (size_t)(t + 2) * kstep;
            const char* a3 = a2 + kstep; const char* b3 = b2 + kstep;
            if (last && has_next) S.a_ready(nxt);
            if constexpr (SP2) {
            PG8_LDB(B0, 0, 0); PG8_LDB(B1, 0, 1); PG8_SCHED; PG8_LDA(At, 0, 0); PG8_STAGE(PG8_SA(1, 1), a1 + hstepA, voffA);
            PG8_WAIT_V(8); PG8_WAIT_L(0); PG8_BAR; PG8_MMA(0, 0, At, B0); PG8_MMA(0, 1, At, B1); PG8_BAR; PG8_SCHED;
            PG8_LDA(At, 0, 1); PG8_STAGE(PG8_SB(0, 0), b2, voffB); PG8_STAGE(PG8_SB(0, 1), b2 + hstepB, voffB); PG8_STAGE(PG8_SA(0, 0), a2, voffA);
            PG8_WAIT_V(8); PG8_WAIT_L(0); PG8_BAR; PG8_MMA(1, 0, At, B0); PG8_MMA(1, 1, At, B1); PG8_BAR; PG8_SCHED;
            PG8_LDB(B0, 1, 0); PG8_LDB(B1, 1, 1); PG8_SCHED; PG8_LDA(At, 1, 0); PG8_STAGE(PG8_SA(0, 1), a2 + hstepA, voffA);
            PG8_WAIT_V(8); PG8_WAIT_L(0); PG8_BAR; PG8_MMA(0, 0, At, B0); PG8_MMA(0, 1, At, B1); PG8_BAR; PG8_SCHED;
            PG8_LDA(At, 1, 1); PG8_STAGE(PG8_SB(1, 0), b3, voffB); PG8_STAGE(PG8_SB(1, 1), b3 + hstepB, voffB); PG8_STAGE(PG8_SA(1, 0), a3, voffA);
            PG8_WAIT_V(8); PG8_WAIT_L(0); PG8_BAR; PG8_MMA(1, 0, At, B0); PG8_MMA(1, 1, At, B1); PG8_BAR; PG8_SCHED;
            } else {
            PG8_LDB(B0, 0, 0); PG8_SCHED; PG8_LDA(At, 0, 0); PG8_STAGE(PG8_SA(1, 1), a1 + hstepA, voffA);
            PG8_WAIT_L(8); PG8_BAR; PG8_WAIT_L(0); PG8_MMA(0, 0, At, B0); PG8_BAR; PG8_SCHED;
            PG8_LDB(B1, 0, 1); PG8_STAGE(PG8_SB(0, 0), b2, voffB);
            PG8_BAR; PG8_WAIT_L(0); PG8_MMA(0, 1, At, B1); PG8_BAR;
            PG8_LDA(At, 0, 1); PG8_STAGE(PG8_SA(0, 0), a2, voffA);
            PG8_BAR; PG8_WAIT_L(0); PG8_MMA(1, 0, At, B0); PG8_BAR; PG8_SCHED;
            PG8_STAGE(PG8_SB(0, 1), b2 + hstepB, voffB);
            PG8_WAIT_V(6); PG8_BAR; PG8_MMA(1, 1, At, B1); PG8_BAR;
            PG8_LDB(B0, 1, 0); PG8_SCHED; PG8_LDA(At, 1, 0); PG8_STAGE(PG8_SA(0, 1), a2 + hstepA, voffA);
            PG8_WAIT_L(8); PG8_BAR; PG8_WAIT_L(0); PG8_MMA(0, 0, At, B0); PG8_BAR; PG8_SCHED;
            PG8_LDB(B1, 1, 1); PG8_STAGE(PG8_SB(1, 0), b3, voffB);
            PG8_BAR; PG8_WAIT_L(0); PG8_MMA(0, 1, At, B1); PG8_BAR;
            PG8_LDA(At, 1, 1); PG8_STAGE(PG8_SA(1, 0), a3, voffA);
            PG8_BAR; PG8_WAIT_L(0); PG8_MMA(1, 0, At, B0); PG8_BAR; PG8_SCHED;
            PG8_STAGE(PG8_SB(1, 1), b3 + hstepB, voffB);
            PG8_WAIT_V(6); PG8_BAR; PG8_MMA(1, 1, At, B1); PG8_BAR;
            }
        }
        if constexpr (ALIGN_EPI) { if (wr == 0) PG8_BAR; }
        if constexpr (!Epi::AFTER_DRAIN) { E(acc, cur, wr, wc, fr, fq); S.done(cur); }
        if (!has_next) break;
#pragma unroll
        for (int a = 0; a < 2; ++a)
#pragma unroll
            for (int b = 0; b < 2; ++b)
#pragma unroll
                for (int m = 0; m < 4; ++m)
#pragma unroll
                    for (int n = 0; n < 2; ++n) acc[a][b][m][n] = (f32x4){0.f, 0.f, 0.f, 0.f};
        cur = nxt; cA = nA; cB = nB; ++ui;
        if constexpr (ALIGN_EPI) { if (wr == 1) PG8_BAR; }
    }
    PG8_WAIT_V(0);
    if constexpr (!ALIGN_EPI) { if (wr == 0) PG8_BAR; }
    PG8_BAR;
    if constexpr (Epi::AFTER_DRAIN) { E.fused(acc, cur, wr, wc, fr, fq, lds, wid, lane); S.done(cur); }
#undef PG8_SA
#undef PG8_SB
#undef PG8_STAGE
#undef PG8_LDA
#undef PG8_LDB
#undef PG8_MMA
#undef PG8_WAIT_V
#undef PG8_WAIT_L
#undef PG8_BAR
#undef PG8_SCHED
}
}

typedef unsigned short bf16_t;
typedef short bf16x8 __attribute__((ext_vector_type(8)));
typedef short bf16x4 __attribute__((ext_vector_type(4)));
typedef float f32x4 __attribute__((ext_vector_type(4)));
typedef float f32x2 __attribute__((ext_vector_type(2)));
typedef unsigned u32x4 __attribute__((ext_vector_type(4)));
typedef unsigned u32x2 __attribute__((ext_vector_type(2)));

constexpr int DM = 2048, SEQ = 8192, NBATCH = 2, MP = NBATCH * SEQ, MS = 128, MREAL = MP + MS, MPAD = 16640;
constexpr int INW = 8992, LDP = 9216, DFF = 8192, AW = 1024;
constexpr int COL_Q = 0, COL_K = 1024, COL_V = 1280, COL_R = 1536, COL_RK = 2560, COL_RV = 3584, COL_WD = 4608, COL_AD = 4672, COL_GD = 4736, COL_GA = 4896, COL_GB = 6944;
constexpr int RW = 3360;
constexpr int NCH = 16, CHUNK = 512, SUB = 32;
constexpr float ALPHA = 1.189207115002721f;
constexpr float LN_EPS = 1e-5f, GN_EPS = 64e-5f;
constexpr int PAST_LEN = 16384;

constexpr size_t MiB = 1u << 20;
constexpr size_t WS_WIN = 1 * MiB, WS_PU = 1 * MiB, WS_WPA = 37 * MiB, WS_WPR = 41 * MiB, WS_WOUT = 45 * MiB, WS_WUP = 53 * MiB, WS_WDN = 85 * MiB, WS_LORA = 117 * MiB;
constexpr size_t WS_A = 118 * MiB, WS_RWO = WS_A + (size_t)MPAD * AW * 2, WS_P = 183 * MiB, WS_SC = 476 * MiB, WS_PB = 484 * MiB, WS_END = 512 * MiB;
static_assert(WS_A + (size_t)MPAD * DM * 2 <= WS_P && WS_P + (size_t)MPAD * LDP * 2 <= WS_SC, "ws map");
constexpr size_t O_YP = 0, O_YS = 33554432, O_KWP = 33816576, O_VWP = 33882112, O_SHP = 33947648, O_WKVP = 33954368, O_KWS = 34085440, O_VWS = 38279744, O_SHS = 42474048, O_WKVS = 42904128, O_END = 51292736;

constexpr int LDS_BYTES = 147456;
constexpr int NTHREADS = 512;

struct Params { const float* in[28]; float* out; unsigned char* ws; };
#ifndef DBL_MASK
#define DBL_MASK 0
#endif
#define REP(k) _Pragma("unroll") for (int rep_ = 0; rep_ < (((DBL_MASK) >> (k)) & 1) + 1; ++rep_)

typedef __bf16 bf16x2_t __attribute__((ext_vector_type(2)));
__device__ __forceinline__ unsigned pk2s(float lo, float hi) { const f32x2 v = {lo, hi}; const bf16x2_t bb = __builtin_convertvector(v, bf16x2_t); return __builtin_bit_cast(unsigned, bb); }
__device__ __forceinline__ unsigned pk2(float lo, float hi) { unsigned r; asm volatile("v_cvt_pk_bf16_f32 %0, %1, %2" : "=v"(r) : "v"(lo), "v"(hi)); return r; }
__device__ __forceinline__ float bf2f(unsigned short b) { return __uint_as_float(((unsigned)b) << 16); }
__device__ __forceinline__ float bflo(unsigned w) { return __uint_as_float(w << 16); }
__device__ __forceinline__ float bfhi(unsigned w) { return __uint_as_float(w & 0xffff0000u); }
__device__ __forceinline__ float sigmoidf_(float x) { return __builtin_amdgcn_rcpf(1.0f + __expf(-x)); }
__device__ __forceinline__ float wave_sum(float v) {
#pragma unroll
    for (int o = 1; o < 64; o <<= 1) v += __shfl_xor(v, o);
    return v;
}
__device__ __forceinline__ float dpp_f(float x, const int ctrl_sel) {
    int v = __float_as_int(x), r;
    if (ctrl_sel == 0) r = __builtin_amdgcn_update_dpp(0, v, 0xB1, 0xF, 0xF, true);
    else if (ctrl_sel == 1) r = __builtin_amdgcn_update_dpp(0, v, 0x4E, 0xF, 0xF, true);
    else r = __builtin_amdgcn_update_dpp(0, v, 0x141, 0xF, 0xF, true);
    return __int_as_float(r);
}
__device__ __forceinline__ float red8(float x) { x += dpp_f(x, 0); x += dpp_f(x, 1); x += dpp_f(x, 2); return x; }

namespace pg8 {

struct EpiP {
    static constexpr bool PERM = true, AFTER_DRAIN = false;
    bf16_t* P;
    __device__ __forceinline__ void operator()(const f32x4 (&acc)[2][2][4][2], const Unit& u, int wr, int wc, int fr, int fq) const {
        const int row0 = u.pm * BM + wr * 64 + fr;
        const int colt = u.pn * BM + wc * 32 + 8 * fq;
        const bool ropet = (u.pn < 5) && ((wc & 1) == 0);
        const float qs = (u.pn < 4) ? 0.125f : 1.0f;
        const float INV[8] = {1.0f, 0.1939227432012558f, 0.03760603070259094f, 0.007292664609849453f, 0.0014142135623842478f, 0.00027424818836152554f, 5.318296098266728e-05f, 1.0313386155758053e-05f};
#pragma unroll
        for (int ai = 0; ai < 2; ++ai)
#pragma unroll
            for (int m = 0; m < 4; ++m) {
                const int row = row0 + ai * HALF + m * 16;
                float cs[8], sn[8];
                if (ropet) {
                    const int pos = (row < MP) ? (row & (SEQ - 1)) : PAST_LEN;
#pragma unroll
                    for (int i = 0; i < 8; ++i) {
                        const float ang = (float)pos * INV[i];
                        double rev = (double)ang * 0.15915494309189535; rev -= __builtin_rint(rev);
                        const float rf = (float)rev;
                        cs[i] = __builtin_amdgcn_cosf(rf); sn[i] = __builtin_amdgcn_sinf(rf);
                    }
                }
                bf16_t* rowp = P + (size_t)row * LDP + colt;
#pragma unroll
                for (int bj = 0; bj < 2; ++bj) {
                    const f32x4 v0 = acc[ai][bj][m][0], v1 = acc[ai][bj][m][1];
                    float x[8] = {v0[0], v0[1], v0[2], v0[3], v1[0], v1[1], v1[2], v1[3]};
                    if (ropet) {
#pragma unroll
                        for (int i = 0; i < 8; ++i) {
                            const float other = __shfl_xor(x[i], 16);
                            const float rot = (fq == 0) ? (x[i] * cs[i] - other * sn[i]) : (x[i] * cs[i] + other * sn[i]);
                            x[i] = (fq < 2) ? rot : x[i];
                        }
                    }
                    const int col = colt + bj * HALF;
                    if (col >= COL_GA) {
#pragma unroll
                        for (int i = 0; i < 8; ++i) x[i] = sigmoidf_(x[i]);
                    }
                    u32x4 w; w.x = pk2(x[0] * qs, x[1] * qs); w.y = pk2(x[2] * qs, x[3] * qs); w.z = pk2(x[4] * qs, x[5] * qs); w.w = pk2(x[6] * qs, x[7] * qs);
                    *(u32x4*)(rowp + bj * HALF) = w;
                }
            }
    }
};

struct EpiGateA {
    static constexpr bool PERM = false, AFTER_DRAIN = false;
    bf16_t* P; float* U;
    __device__ __forceinline__ void operator()(const f32x4 (&acc)[2][2][4][2], const Unit& u, int wr, int wc, int fr, int fq) const {
        const int row0 = u.pm * BM + wr * 64 + fr, col0 = u.pn * BM + wc * 32 + 4 * fq;
#pragma unroll
        for (int ai = 0; ai < 2; ++ai)
#pragma unroll
            for (int m = 0; m < 4; ++m) {
                const int row = row0 + ai * HALF + m * 16;
                if (row < MREAL) {
#pragma unroll
                    for (int bj = 0; bj < 2; ++bj)
#pragma unroll
                        for (int n = 0; n < 2; ++n) {
                            const int col = col0 + bj * HALF + n * 16;
                            const u32x2 gw = *(const u32x2*)(P + (size_t)row * LDP + COL_GA + col);
                            const f32x4 a = acc[ai][bj][m][n];
                            u32x2 o; o.x = pk2(a[0] * bflo(gw.x), a[1] * bfhi(gw.x)); o.y = pk2(a[2] * bflo(gw.y), a[3] * bfhi(gw.y));
                            *(u32x2*)(P + (size_t)row * LDP + COL_GA + col) = o;
                        }
                }
            }
    }
};
struct EpiGateB {
    static constexpr bool PERM = false, AFTER_DRAIN = false;
    bf16_t* P; const float* U;
    __device__ __forceinline__ void operator()(const f32x4 (&acc)[2][2][4][2], const Unit& u, int wr, int wc, int fr, int fq) const {
        const int row0 = u.pm * BM + wr * 64 + fr, col0 = u.pn * BM + wc * 32 + 4 * fq;
#pragma unroll
        for (int ai = 0; ai < 2; ++ai)
#pragma unroll
            for (int m = 0; m < 4; ++m) {
                const int row = row0 + ai * HALF + m * 16;
                if (row < MREAL) {
#pragma unroll
                    for (int bj = 0; bj < 2; ++bj)
#pragma unroll
                        for (int n = 0; n < 2; ++n) {
                            const int col = col0 + bj * HALF + n * 16;
                            const u32x2 gw = *(const u32x2*)(P + (size_t)row * LDP + COL_GB + col);
                            const f32x4 a = acc[ai][bj][m][n];
                            const u32x2 uw = *(const u32x2*)(P + (size_t)row * LDP + COL_GA + col);
                            u32x2 o; o.x = pk2(bflo(uw.x) + a[0] * bflo(gw.x), bfhi(uw.x) + a[1] * bfhi(gw.x)); o.y = pk2(bflo(uw.y) + a[2] * bflo(gw.y), bfhi(uw.y) + a[3] * bfhi(gw.y));
                            *(u32x2*)(P + (size_t)row * LDP + COL_GA + col) = o;
                        }
                }
            }
    }
};
struct EpiResid {
    static constexpr bool PERM = false, AFTER_DRAIN = false;
    const float* xp; const float* xs; bf16_t* ZB; int ldz; const bf16_t* hb;
    __device__ __forceinline__ void operator()(const f32x4 (&acc)[2][2][4][2], const Unit& u, int wr, int wc, int fr, int fq) const {
        const int row0 = u.pm * BM + wr * 64 + fr, col0 = u.pn * BM + wc * 32 + 4 * fq;
#pragma unroll
        for (int ai = 0; ai < 2; ++ai)
#pragma unroll
            for (int m = 0; m < 4; ++m) {
                const int row = row0 + ai * HALF + m * 16;
                if (row < MREAL) {
                    const float* bp = xp ? ((row < MP) ? xp + (size_t)row * DM : xs + (size_t)(row - MP) * DM) : nullptr;
#pragma unroll
                    for (int bj = 0; bj < 2; ++bj)
#pragma unroll
                        for (int n = 0; n < 2; ++n) {
                            const int col = col0 + bj * HALF + n * 16;
                            f32x4 bs;
                            if (xp) bs = *(const f32x4*)(bp + col);
                            else { const u32x2 hw = *(const u32x2*)(hb + (size_t)row * DM + col); bs = (f32x4){bflo(hw.x), bfhi(hw.x), bflo(hw.y), bfhi(hw.y)}; }
                            const f32x4 z = bs * ALPHA + acc[ai][bj][m][n];
                            u32x2 zw; zw.x = pk2(z[0], z[1]); zw.y = pk2(z[2], z[3]);
                            *(u32x2*)(ZB + (size_t)row * ldz + col) = zw;
                        }
                }
            }
    }
};
struct EpiUp {
    static constexpr bool PERM = true, AFTER_DRAIN = false;
    bf16_t* U;
    __device__ __forceinline__ void operator()(const f32x4 (&acc)[2][2][4][2], const Unit& u, int wr, int wc, int fr, int fq) const {
        const int row0 = u.pm * BM + wr * 64 + fr, col0 = u.pn * BM + wc * 32 + 8 * fq;
#pragma unroll
        for (int ai = 0; ai < 2; ++ai)
#pragma unroll
            for (int m = 0; m < 4; ++m) {
                bf16_t* rowp = U + (size_t)(row0 + ai * HALF + m * 16) * DFF + col0;
#pragma unroll
                for (int bj = 0; bj < 2; ++bj) {
                    f32x4 v0 = acc[ai][bj][m][0], v1 = acc[ai][bj][m][1];
#pragma unroll
                    for (int i = 0; i < 4; ++i) { const float a = fmaxf(v0[i], 0.f), b = fmaxf(v1[i], 0.f); v0[i] = a * a; v1[i] = b * b; }
                    u32x4 w; w.x = pk2(v0[0], v0[1]); w.y = pk2(v0[2], v0[3]); w.z = pk2(v1[0], v1[1]); w.w = pk2(v1[2], v1[3]);
                    *(u32x4*)(rowp + bj * HALF) = w;
                }
            }
    }
};

struct TailOrder {
    int nN, KS, nslot, G, c, pm; long ksA, ksB, DA, DB;
    __device__ bool next(int i, Unit& u) const {
        const int L = i * G + c; if (L >= nN * nslot) return false;
        u.pm = pm; u.pn = L / nslot; u.slot = L % nslot; const int which = u.slot / KS, kk = u.slot % KS;
        u.offA = which * DA + kk * ksA; u.offB = which * DB + kk * ksB; return true;
    }
    __device__ __forceinline__ void a_ready(const Unit&) const {}
    __device__ __forceinline__ void done(const Unit&) const {}
};
struct TailArgs { float* part; unsigned* cnt; int N, nslot; PG8_LAS unsigned* flag; bf16_t* P; const float* base; bf16_t* ZB; int ldz; const bf16_t* hb; };
template <int KIND, int KS>
__device__ __forceinline__ void tail_finalize(const TailArgs& a, int pn) {
    const int t = threadIdx.x, cg = t & 15;
    const int col0 = pn * BM + cg * 16;
#pragma unroll 1
    for (int i = 0; i < 4; ++i) {
        const int row = (t >> 4) + 32 * i;
        const float* src = a.part + (size_t)row * a.N + col0;
        float x[16], y[16];
#pragma unroll
        for (int q = 0; q < 4; ++q) { f32x4 sa = (f32x4){0.f, 0.f, 0.f, 0.f}, sb = sa;
#pragma unroll
            for (int sl = 0; sl < KS; ++sl) sa += *(const f32x4*)(src + (size_t)sl * 128 * a.N + 4 * q);
            if (KIND == 1) {
#pragma unroll
                for (int sl = KS; sl < 2 * KS; ++sl) sb += *(const f32x4*)(src + (size_t)sl * 128 * a.N + 4 * q); }
#pragma unroll
            for (int j = 0; j < 4; ++j) { x[4 * q + j] = sa[j]; y[4 * q + j] = sb[j]; } }
        const size_t grow = (size_t)(MP + row);
        if (KIND == 0) {
            if (pn < 5 && (col0 & 63) == 0) {
                const float INV[8] = {1.0f, 0.1939227432012558f, 0.03760603070259094f, 0.007292664609849453f, 0.0014142135623842478f, 0.00027424818836152554f, 5.318296098266728e-05f, 1.0313386155758053e-05f};
#pragma unroll
                for (int k = 0; k < 8; ++k) { const float ang = (float)PAST_LEN * INV[k]; double rev = (double)ang * 0.15915494309189535; rev -= __builtin_rint(rev); const float rf = (float)rev;
                    const float cs = __builtin_amdgcn_cosf(rf), sn = __builtin_amdgcn_sinf(rf); const float x1 = x[k], x2 = x[k + 8]; x[k] = x1 * cs - x2 * sn; x[k + 8] = x2 * cs + x1 * sn; }
            }
            const float qs = (pn < 4) ? 0.125f : 1.0f;
            if (col0 >= COL_GA) {
#pragma unroll
                for (int k = 0; k < 16; ++k) x[k] = sigmoidf_(x[k]); }
            u32x4 w0, w1; w0.x = pk2(x[0] * qs, x[1] * qs); w0.y = pk2(x[2] * qs, x[3] * qs); w0.z = pk2(x[4] * qs, x[5] * qs); w0.w = pk2(x[6] * qs, x[7] * qs);
            w1.x = pk2(x[8] * qs, x[9] * qs); w1.y = pk2(x[10] * qs, x[11] * qs); w1.z = pk2(x[12] * qs, x[13] * qs); w1.w = pk2(x[14] * qs, x[15] * qs);
            *(u32x4*)(a.P + grow * LDP + col0) = w0; *(u32x4*)(a.P + grow * LDP + col0 + 8) = w1;
        } else if (KIND == 1) {
            const u32x4 ga0 = *(const u32x4*)(a.P + grow * LDP + COL_GA + col0), ga1 = *(const u32x4*)(a.P + grow * LDP + COL_GA + col0 + 8);
            const u32x4 gb0 = *(const u32x4*)(a.P + grow * LDP + COL_GB + col0), gb1 = *(const u32x4*)(a.P + grow * LDP + COL_GB + col0 + 8);
            float ga[16], gb[16];
            { float u8[8]; u8[0] = bflo(ga0.x); u8[1] = bfhi(ga0.x); u8[2] = bflo(ga0.y); u8[3] = bfhi(ga0.y); u8[4] = bflo(ga0.z); u8[5] = bfhi(ga0.z); u8[6] = bflo(ga0.w); u8[7] = bfhi(ga0.w);
#pragma unroll
              for (int k = 0; k < 8; ++k) ga[k] = u8[k];
              u8[0] = bflo(ga1.x); u8[1] = bfhi(ga1.x); u8[2] = bflo(ga1.y); u8[3] = bfhi(ga1.y); u8[4] = bflo(ga1.z); u8[5] = bfhi(ga1.z); u8[6] = bflo(ga1.w); u8[7] = bfhi(ga1.w);
#pragma unroll
              for (int k = 0; k < 8; ++k) ga[8 + k] = u8[k];
              u8[0] = bflo(gb0.x); u8[1] = bfhi(gb0.x); u8[2] = bflo(gb0.y); u8[3] = bfhi(gb0.y); u8[4] = bflo(gb0.z); u8[5] = bfhi(gb0.z); u8[6] = bflo(gb0.w); u8[7] = bfhi(gb0.w);
#pragma unroll
              for (int k = 0; k < 8; ++k) gb[k] = u8[k];
              u8[0] = bflo(gb1.x); u8[1] = bfhi(gb1.x); u8[2] = bflo(gb1.y); u8[3] = bfhi(gb1.y); u8[4] = bflo(gb1.z); u8[5] = bfhi(gb1.z); u8[6] = bflo(gb1.w); u8[7] = bfhi(gb1.w);
#pragma unroll
              for (int k = 0; k < 8; ++k) gb[8 + k] = u8[k]; }
            float o[16];
#pragma unroll
            for (int k = 0; k < 16; ++k) o[k] = x[k] * ga[k] + y[k] * gb[k];
            u32x4 w0, w1; w0.x = pk2(o[0], o[1]); w0.y = pk2(o[2], o[3]); w0.z = pk2(o[4], o[5]); w0.w = pk2(o[6], o[7]);
            w1.x = pk2(o[8], o[9]); w1.y = pk2(o[10], o[11]); w1.z = pk2(o[12], o[13]); w1.w = pk2(o[14], o[15]);
            *(u32x4*)(a.P + grow * LDP + COL_GA + col0) = w0; *(u32x4*)(a.P + grow * LDP + COL_GA + col0 + 8) = w1;
        } else if (KIND == 2) {
            float z[16];
#pragma unroll
            for (int q = 0; q < 4; ++q) { f32x4 bs;
                if (a.base) bs = *(const f32x4*)(a.base + (size_t)row * DM + col0 + 4 * q);
                else { const u32x2 hw = *(const u32x2*)(a.hb + grow * DM + col0 + 4 * q); bs = (f32x4){bflo(hw.x), bfhi(hw.x), bflo(hw.y), bfhi(hw.y)}; }
#pragma unroll
                for (int e = 0; e < 4; ++e) z[4 * q + e] = bs[e] * ALPHA + x[4 * q + e]; }
            u32x4 w0, w1; w0.x = pk2(z[0], z[1]); w0.y = pk2(z[2], z[3]); w0.z = pk2(z[4], z[5]); w0.w = pk2(z[6], z[7]);
            w1.x = pk2(z[8], z[9]); w1.y = pk2(z[10], z[11]); w1.z = pk2(z[12], z[13]); w1.w = pk2(z[14], z[15]);
            *(u32x4*)(a.ZB + grow * a.ldz + col0) = w0; *(u32x4*)(a.ZB + grow * a.ldz + col0 + 8) = w1;
        } else {
#pragma unroll
            for (int k = 0; k < 16; ++k) { const float r = fmaxf(x[k], 0.f); x[k] = r * r; }
            u32x4 w0, w1; w0.x = pk2(x[0], x[1]); w0.y = pk2(x[2], x[3]); w0.z = pk2(x[4], x[5]); w0.w = pk2(x[6], x[7]);
            w1.x = pk2(x[8], x[9]); w1.y = pk2(x[10], x[11]); w1.z = pk2(x[12], x[13]); w1.w = pk2(x[14], x[15]);
            *(u32x4*)(a.P + grow * DFF + col0) = w0; *(u32x4*)(a.P + grow * DFF + col0 + 8) = w1;
        }
    }
}
template <bool PERM_, int KIND, int KS> struct EpiTail {
    static constexpr bool PERM = PERM_, AFTER_DRAIN = false;
    TailArgs a;
    __device__ __forceinline__ void operator()(const f32x4 (&acc)[2][2][4][2], const Unit& u, int wr, int wc, int fr, int fq) const {
        const int cbase = u.pn * BM + wc * 32 + (PERM ? 8 * fq : 4 * fq);
#pragma unroll
        for (int m = 0; m < 4; ++m)
#pragma unroll
            for (int bj = 0; bj < 2; ++bj)
#pragma unroll
                for (int n = 0; n < 2; ++n)
                    *(f32x4*)(a.part + ((size_t)u.slot * 128 + wr * 64 + m * 16 + fr) * a.N + cbase + bj * HALF + (PERM ? 4 * n : 16 * n)) = acc[0][bj][m][n];
        asm volatile("s_waitcnt vmcnt(0) lgkmcnt(0)" ::: "memory");
        __builtin_amdgcn_s_barrier();
        if (threadIdx.x == 0) {
            __builtin_amdgcn_fence(__ATOMIC_RELEASE, "agent");
            asm volatile("s_waitcnt vmcnt(0)" ::: "memory");
            const unsigned old = __hip_atomic_fetch_add(a.cnt + u.pn, 1u, __ATOMIC_RELAXED, __HIP_MEMORY_SCOPE_AGENT); a.flag[0] = (old == (unsigned)(a.nslot - 1)) ? 1u : 0u; }
        asm volatile("s_waitcnt vmcnt(0) lgkmcnt(0)" ::: "memory");
        __builtin_amdgcn_s_barrier();
        asm volatile("" ::: "memory");
        const bool last = a.flag[0] != 0u;
        if (last) {
            __builtin_amdgcn_fence(__ATOMIC_ACQUIRE, "agent");
            asm volatile("s_waitcnt vmcnt(0)" ::: "memory");
            tail_finalize<KIND, KS>(a, u.pn);
        }
    }
};
}

__device__ __forceinline__ void p0_transpose_item(const float* W, int K, int N, bf16_t* WT, float* scr, int item, int lane) {
    const int nblk = N / 32, kb = item / nblk, nb = item % nblk, k0 = 64 * kb, n0 = 32 * nb;
#pragma unroll 8
    for (int i = 0; i < 32; ++i) { const int kk = 2 * i + (lane >> 5); scr[kk * 33 + (lane & 31)] = W[(size_t)(k0 + kk) * N + n0 + (lane & 31)]; }
    asm volatile("s_waitcnt lgkmcnt(0)" ::: "memory");
    const int c = lane & 7;
#pragma unroll
    for (int j = 0; j < 4; ++j) { const int n = (lane >> 3) + 8 * j; const float* s = scr + (8 * c) * 33 + n;
        u32x4 o; o.x = pk2(s[0 * 33], s[1 * 33]); o.y = pk2(s[2 * 33], s[3 * 33]); o.z = pk2(s[4 * 33], s[5 * 33]); o.w = pk2(s[6 * 33], s[7 * 33]);
        *(u32x4*)(WT + (size_t)(n0 + n) * K + k0 + 8 * c) = o; }
    asm volatile("s_waitcnt lgkmcnt(0)" ::: "memory");
}

__device__ __forceinline__ void phase0(const Params& p, unsigned char* lds) {
    const int tid = otid(), lane = tid & 63, wv = tid >> 6;
    const int G = gridDim.x, gw = blockIdx.x * 8 + wv, NGW = G * 8;
    const long gt = (long)blockIdx.x * NTHREADS + tid, NGT = (long)G * NTHREADS;
    unsigned char* ws = p.ws;
    float* scr = (float*)(lds + wv * 16384);
    constexpr int I_IN = 32 * 281, I_PA = 16 * 64, I_OUT = 32 * 64, I_UP = 32 * 256, I_DN = 128 * 64;
    constexpr int NIT = I_IN + 2 * I_PA + I_OUT + I_UP + I_DN;
    for (int it = gw; it < NIT; it += NGW) {
        int r = it;
        if (r < I_IN) { p0_transpose_item(p.in[6], DM, INW, (bf16_t*)(ws + WS_WIN), scr, r, lane); continue; } r -= I_IN;
        if (r < I_PA) { p0_transpose_item(p.in[19], AW, DM, (bf16_t*)(ws + WS_WPA), scr, r, lane); continue; } r -= I_PA;
        if (r < I_PA) { p0_transpose_item(p.in[20], AW, DM, (bf16_t*)(ws + WS_WPR), scr, r, lane); continue; } r -= I_PA;
        if (r < I_OUT) { p0_transpose_item(p.in[21], DM, DM, (bf16_t*)(ws + WS_WOUT), scr, r, lane); continue; } r -= I_OUT;
        if (r < I_UP) { p0_transpose_item(p.in[24], DM, DFF, (bf16_t*)(ws + WS_WUP), scr, r, lane); continue; } r -= I_UP;
        p0_transpose_item(p.in[25], DFF, DM, (bf16_t*)(ws + WS_WDN), scr, r, lane);
    }
    { u32x4* z = (u32x4*)(ws + WS_WIN + (size_t)INW * DM * 2); const long n16 = (long)(LDP - INW) * DM * 2 / 16;
      for (long e = gt; e < n16; e += NGT) z[e] = (u32x4){0u, 0u, 0u, 0u}; }
    { bf16_t* WdT = (bf16_t*)(ws + WS_LORA); bf16_t* WaT = WdT + 1024 * 64; bf16_t* WgT = WaT + 1024 * 64;
      const float* Wd = p.in[10]; const float* Wa = p.in[12]; const float* Wg = p.in[13];
      for (long e = gt; e < 1024 * 64; e += NGT) { const int n = (int)(e >> 6), k = (int)(e & 63); WdT[e] = (bf16_t)(pk2(Wd[k * 1024 + n], 0.f) & 0xffffu); WaT[e] = (bf16_t)(pk2(Wa[k * 1024 + n], 0.f) & 0xffffu); }
      for (long e = gt; e < 1024 * 160; e += NGT) { const int n = (int)(e / 160), k = (int)(e % 160); WgT[e] = (bf16_t)(pk2(Wg[k * 1024 + n], 0.f) & 0xffffu); } }
    { bf16_t* Xb = (bf16_t*)(ws + WS_A); const float* xp = p.in[0]; const float* xs = p.in[1];
      for (long e = gt; e < (long)MPAD * 256; e += NGT) { const int row = (int)(e >> 8), c8 = (int)(e & 255) * 8;
          u32x4 o = (u32x4){0u, 0u, 0u, 0u};
          if (row < MREAL) { const float* src = (row < MP) ? xp + (size_t)row * DM + c8 : xs + (size_t)(row - MP) * DM + c8;
              const f32x4 a = *(const f32x4*)src, b = *(const f32x4*)(src + 4);
              o.x = pk2(a[0], a[1]); o.y = pk2(a[2], a[3]); o.z = pk2(b[0], b[1]); o.w = pk2(b[2], b[3]); }
          *(u32x4*)(Xb + (size_t)row * DM + c8) = o; } }
}

__device__ __forceinline__ void attn_prompt_unit(unsigned char* lds, const bf16_t* P, bf16_t* attn_o, const float* sinks, int unit) {
    const int qblk = unit & 63, kvh = (unit >> 6) & 3, b = unit >> 8;
    const int tid = otid(), lane = tid & 63, wid = tid >> 6, fr = lane & 15, fq = lane >> 4;
    bf16_t* Ks = (bf16_t*)lds;
    bf16_t* Vt = (bf16_t*)(lds + 256 * 144);
    const long row0 = (long)b * SEQ + (long)(qblk - 1) * 128;
    const long tokrow = (long)b * SEQ + (long)qblk * 128 + 16 * wid + fr;
    bf16x8 qf[4][2];
#pragma unroll
    for (int g = 0; g < 4; ++g) { const bf16_t* qp = P + (size_t)tokrow * LDP + COL_Q + (kvh * 4 + g) * 64 + fq * 8; qf[g][0] = *(const bf16x8*)(qp); qf[g][1] = *(const bf16x8*)(qp + 32); }
#pragma unroll
    for (int i = 0; i < 4; ++i) {
        const int ch = tid + i * NTHREADS; const int key = ch >> 3, c8 = ch & 7;
        u32x4 kv = (u32x4){0u, 0u, 0u, 0u}, vv = (u32x4){0u, 0u, 0u, 0u};
        if (qblk > 0 || key >= 128) {
            const bf16_t* src = P + (size_t)(row0 + key) * LDP + kvh * 64 + c8 * 8;
            kv = *(const u32x4*)(src + COL_K); vv = *(const u32x4*)(src + COL_V);
        }
        *(u32x4*)(Ks + key * 72 + c8 * 8) = kv;
        bf16_t* vd = Vt + (c8 * 8) * 264 + key;
        vd[0 * 264] = (bf16_t)(vv.x & 0xffffu); vd[1 * 264] = (bf16_t)(vv.x >> 16);
        vd[2 * 264] = (bf16_t)(vv.y & 0xffffu); vd[3 * 264] = (bf16_t)(vv.y >> 16);
        vd[4 * 264] = (bf16_t)(vv.z & 0xffffu); vd[5 * 264] = (bf16_t)(vv.z >> 16);
        vd[6 * 264] = (bf16_t)(vv.w & 0xffffu); vd[7 * 264] = (bf16_t)(vv.w >> 16);
    }
    __syncthreads();
    const int qrel = 128 + 16 * wid + fr;
    const int kb0 = wid & ~1;
    const float L2E = 1.4426950408889634f;
#pragma unroll
    for (int g = 0; g < 4; ++g) {
        const int head = kvh * 4 + g;
        const bf16x8 qf0 = qf[g][0], qf1 = qf[g][1];
        f32x4 s[10];
#pragma unroll
        for (int jb = 0; jb < 10; ++jb) {
            const bf16_t* kp = Ks + (16 * (kb0 + jb) + fr) * 72 + fq * 8;
            const bf16x8 k0 = *(const bf16x8*)(kp), k1 = *(const bf16x8*)(kp + 32);
            f32x4 a = (f32x4){0.f, 0.f, 0.f, 0.f};
            a = __builtin_amdgcn_mfma_f32_16x16x32_bf16(k0, qf0, a, 0, 0, 0);
            a = __builtin_amdgcn_mfma_f32_16x16x32_bf16(k1, qf1, a, 0, 0, 0);
            s[jb] = a;
        }
        const float sink = sinks[head];
        float mx = sink;
#pragma unroll
        for (int jb = 0; jb < 10; ++jb)
#pragma unroll
            for (int j = 0; j < 4; ++j) {
                const int kidx = 16 * (kb0 + jb) + 4 * fq + j;
                const bool ok = (kidx <= qrel) && (kidx > qrel - 128) && (qblk > 0 || kidx >= 128);
                const float v = ok ? s[jb][j] : -INFINITY;
                s[jb][j] = v; mx = fmaxf(mx, v);
            }
        mx = fmaxf(mx, __shfl_xor(mx, 16)); mx = fmaxf(mx, __shfl_xor(mx, 32));
        float l = 0.f;
#pragma unroll
        for (int jb = 0; jb < 10; ++jb)
#pragma unroll
            for (int j = 0; j < 4; ++j) { const float e = __builtin_amdgcn_exp2f((s[jb][j] - mx) * L2E); s[jb][j] = e; l += e; }
        l += __shfl_xor(l, 16); l += __shfl_xor(l, 32);
        l += __builtin_amdgcn_exp2f((sink - mx) * L2E);
        const float rl = 1.0f / l;
        f32x4 o[4];
#pragma unroll
        for (int db = 0; db < 4; ++db) o[db] = (f32x4){0.f, 0.f, 0.f, 0.f};
#pragma unroll
        for (int G2 = 0; G2 < 5; ++G2) {
            u32x4 pw; pw.x = pk2s(s[2 * G2][0], s[2 * G2][1]); pw.y = pk2s(s[2 * G2][2], s[2 * G2][3]); pw.z = pk2s(s[2 * G2 + 1][0], s[2 * G2 + 1][1]); pw.w = pk2s(s[2 * G2 + 1][2], s[2 * G2 + 1][3]);
            const bf16x8 pb = __builtin_bit_cast(bf16x8, pw);
#pragma unroll
            for (int db = 0; db < 4; ++db) {
                const bf16_t* vp = Vt + (16 * db + fr) * 264 + 16 * (kb0 + 2 * G2) + 4 * fq;
                const u32x2 v0 = *(const u32x2*)(vp), v1 = *(const u32x2*)(vp + 16);
                u32x4 vw; vw.x = v0.x; vw.y = v0.y; vw.z = v1.x; vw.w = v1.y;
                o[db] = __builtin_amdgcn_mfma_f32_16x16x32_bf16(__builtin_bit_cast(bf16x8, vw), pb, o[db], 0, 0, 0);
            }
        }
        bf16_t* op = attn_o + (size_t)tokrow * AW + head * 64 + 4 * fq;
#pragma unroll
        for (int db = 0; db < 4; ++db) { u32x2 w; w.x = pk2(o[db][0] * rl, o[db][1] * rl); w.y = pk2(o[db][2] * rl, o[db][3] * rl); *(u32x2*)(op + 16 * db) = w; }
    }
    __syncthreads();
}

__device__ __forceinline__ void attn_sample_unit(const Params& p, const bf16_t* P, bf16_t* attn_o, unsigned char* lds, int unit) {
    const int b = unit >> 2, kvh = unit & 3, tid = otid();
    float* Kc = (float*)lds;
    float* Vc = Kc + 128 * 68;
    float* Kn = Vc + 128 * 64;
    float* Vn = Kn + 64;
    float* qs = Vn + 64;
    float* sc = qs + 256;
    const float* ck = p.in[2] + ((size_t)b * 128 * 4 + kvh) * 64;
    const float* cv = p.in[3] + ((size_t)b * 128 * 4 + kvh) * 64;
    float* ok = p.out + O_KWS + ((size_t)b * 128 * 4 + kvh) * 64;
    float* ov = p.out + O_VWS + ((size_t)b * 128 * 4 + kvh) * 64;
    const bf16_t* prow = P + (size_t)(MP + b) * LDP;
    f32x4 kr[4], vr[4];
#pragma unroll
    for (int i = 0; i < 4; ++i) { const int idx = tid + i * NTHREADS, key = idx >> 4, c4 = (idx & 15) * 4;
        kr[i] = *(const f32x4*)(ck + (size_t)key * 256 + c4); vr[i] = *(const f32x4*)(cv + (size_t)key * 256 + c4); }
#pragma unroll
    for (int i = 0; i < 4; ++i) { const int idx = tid + i * NTHREADS, key = idx >> 4, c4 = (idx & 15) * 4;
        *(f32x4*)(Kc + key * 68 + c4) = kr[i]; *(f32x4*)(Vc + key * 64 + c4) = vr[i];
        if (key >= 1) { *(f32x4*)(ok + (size_t)(key - 1) * 256 + c4) = kr[i]; *(f32x4*)(ov + (size_t)(key - 1) * 256 + c4) = vr[i]; } }
    if (tid < 64) { const float kn = bf2f(prow[COL_K + kvh * 64 + tid]), vn = bf2f(prow[COL_V + kvh * 64 + tid]);
        Kn[tid] = kn; Vn[tid] = vn; ok[(size_t)127 * 256 + tid] = kn; ov[(size_t)127 * 256 + tid] = vn; }
    else if (tid < 320) { const int e = tid - 64; qs[e] = bf2f(prow[COL_Q + kvh * 256 + e]); }
    __syncthreads();
    { const int h = tid >> 7, key = tid & 127;
      const float* qh = qs + h * 64; const float* kp = (key == 0) ? Kn : Kc + key * 68;
      float s0 = 0.f, s1 = 0.f;
#pragma unroll
      for (int d = 0; d < 64; d += 8) { const f32x4 ka = *(const f32x4*)(kp + d), kb = *(const f32x4*)(kp + d + 4), qa = *(const f32x4*)(qh + d), qb = *(const f32x4*)(qh + d + 4);
          s0 += ka[0] * qa[0] + ka[1] * qa[1] + ka[2] * qa[2] + ka[3] * qa[3]; s1 += kb[0] * qb[0] + kb[1] * qb[1] + kb[2] * qb[2] + kb[3] * qb[3]; }
      sc[h * 132 + ((key == 0) ? 128 : key)] = s0 + s1; }
    __syncthreads();
    if (tid < 256) { const int h = tid >> 6, d = tid & 63; const float* sh = sc + h * 132;
        const float sink = p.in[7][kvh * 4 + h];
        float m = sink;
        for (int k = 1; k <= 128; ++k) m = fmaxf(m, sh[k]);
        float l = __expf(sink - m), o = 0.f;
#pragma unroll 4
        for (int k = 1; k < 128; ++k) { const float e = __expf(sh[k] - m); l += e; o += e * Vc[k * 64 + d]; }
        { const float e = __expf(sh[128] - m); l += e; o += e * Vn[d]; }
        attn_o[(size_t)(MP + b) * AW + (kvh * 4 + h) * 64 + d] = (bf16_t)(pk2(o / l, 0.f) & 0xffffu); }
    __syncthreads();
}

__device__ __forceinline__ void lerp8(const bf16_t* prow, const float* sprev, const float* mu, bool is_s, bool first, int col, float (&x)[8]) {
    const u32x4 c = *(const u32x4*)(prow + col);
    const float cur[8] = {bflo(c.x), bfhi(c.x), bflo(c.y), bfhi(c.y), bflo(c.z), bfhi(c.z), bflo(c.w), bfhi(c.w)};
    float pv[8];
    if (is_s) { const f32x4 a = *(const f32x4*)(sprev + col - COL_R), bq = *(const f32x4*)(sprev + col - COL_R + 4);
        pv[0] = a[0]; pv[1] = a[1]; pv[2] = a[2]; pv[3] = a[3]; pv[4] = bq[0]; pv[5] = bq[1]; pv[6] = bq[2]; pv[7] = bq[3]; }
    else if (first) {
#pragma unroll
        for (int i = 0; i < 8; ++i) pv[i] = 0.f; }
    else { const u32x4 q = *(const u32x4*)(prow - LDP + col);
        pv[0] = bflo(q.x); pv[1] = bfhi(q.x); pv[2] = bflo(q.y); pv[3] = bfhi(q.y); pv[4] = bflo(q.z); pv[5] = bfhi(q.z); pv[6] = bflo(q.w); pv[7] = bfhi(q.w); }
    const f32x4 m0 = *(const f32x4*)(mu + col - COL_R), m1 = *(const f32x4*)(mu + col - COL_R + 4);
    const float mm[8] = {m0[0], m0[1], m0[2], m0[3], m1[0], m1[1], m1[2], m1[3]};
#pragma unroll
    for (int i = 0; i < 8; ++i) x[i] = cur[i] + (pv[i] - cur[i]) * mm[i];
}

__device__ __forceinline__ void lora_wave_unit(const Params& p, const bf16_t* P, int wu, int nb0, int nbn, int lane) {
    const int fr = lane & 15, fq = lane >> 4;
    const int row = wu * 16 + fr;
    const bool is_s = row >= MP; const bool first = (row & (SEQ - 1)) == 0;
    const bf16_t* prow = P + (size_t)row * LDP;
    const float* sprev = p.in[4] + (size_t)(is_s ? row - MP : 0) * RW;
    const float* mu = p.in[8];
    bf16x8 actw[2], acta[2], actg[5];
#pragma unroll
    for (int kk = 0; kk < 2; ++kk) {
        float x[8]; lerp8(prow, sprev, mu, is_s, first, COL_WD + 32 * kk + 8 * fq, x);
#pragma unroll
        for (int i = 0; i < 8; ++i) { const float e = __expf(2.f * x[i]); x[i] = 1.f - 2.f / (e + 1.f); }
        u32x4 w; w.x = pk2(x[0], x[1]); w.y = pk2(x[2], x[3]); w.z = pk2(x[4], x[5]); w.w = pk2(x[6], x[7]); actw[kk] = __builtin_bit_cast(bf16x8, w);
        lerp8(prow, sprev, mu, is_s, first, COL_AD + 32 * kk + 8 * fq, x);
        w.x = pk2(x[0], x[1]); w.y = pk2(x[2], x[3]); w.z = pk2(x[4], x[5]); w.w = pk2(x[6], x[7]); acta[kk] = __builtin_bit_cast(bf16x8, w);
    }
#pragma unroll
    for (int kk = 0; kk < 5; ++kk) {
        float x[8]; lerp8(prow, sprev, mu, is_s, first, COL_GD + 32 * kk + 8 * fq, x);
#pragma unroll
        for (int i = 0; i < 8; ++i) x[i] = sigmoidf_(x[i]);
        u32x4 w; w.x = pk2s(x[0], x[1]); w.y = pk2s(x[2], x[3]); w.z = pk2s(x[4], x[5]); w.w = pk2s(x[6], x[7]); actg[kk] = __builtin_bit_cast(bf16x8, w);
    }
    const bf16_t* WdT = (const bf16_t*)(p.ws + WS_LORA); const bf16_t* WaT = WdT + 1024 * 64; const bf16_t* WgT = WaT + 1024 * 64;
    const float* w0 = p.in[9]; const float* a0 = p.in[11];
    unsigned char* lw = (unsigned char*)p.out + (size_t)row * 8192;
#define LORA_LOAD(WD, WA, WG, W0V, A0V, NB) do { const int c_ = (NB) * 16 + fr; \
        _Pragma("unroll") for (int kk = 0; kk < 2; ++kk) { WD[kk] = *(const bf16x8*)(WdT + c_ * 64 + kk * 32 + fq * 8); WA[kk] = *(const bf16x8*)(WaT + c_ * 64 + kk * 32 + fq * 8); } \
        _Pragma("unroll") for (int kk = 0; kk < 5; ++kk) WG[kk] = *(const bf16x8*)(WgT + c_ * 160 + kk * 32 + fq * 8); \
        W0V = *(const f32x4*)(w0 + (NB) * 16 + 4 * fq); A0V = *(const f32x4*)(a0 + (NB) * 16 + 4 * fq); } while (0)
#define LORA_COMPUTE(WD, WA, WG, W0V, A0V, NB) do { \
        f32x4 accw = (f32x4){0.f, 0.f, 0.f, 0.f}, acca = accw, accg = accw; \
        _Pragma("unroll") for (int kk = 0; kk < 2; ++kk) { \
            accw = __builtin_amdgcn_mfma_f32_16x16x32_bf16(WD[kk], actw[kk], accw, 0, 0, 0); \
            acca = __builtin_amdgcn_mfma_f32_16x16x32_bf16(WA[kk], acta[kk], acca, 0, 0, 0); } \
        _Pragma("unroll") for (int kk = 0; kk < 5; ++kk) accg = __builtin_amdgcn_mfma_f32_16x16x32_bf16(WG[kk], actg[kk], accg, 0, 0, 0); \
        const int cc = (NB) * 16 + 4 * fq; \
        f32x4 dec; float av[4]; \
        _Pragma("unroll") for (int j = 0; j < 4; ++j) { \
            const float xx = -(W0V[j] + accw[j]); \
            const float sp = fmaxf(xx, 0.f) + __logf(1.f + __expf(-fabsf(xx))); \
            dec[j] = __expf(-__expf(-sp - 0.5f)); \
            av[j] = sigmoidf_(A0V[j] + acca[j]); } \
        *(f32x4*)(lw + (size_t)cc * 4) = dec; \
        u32x2 aw; aw.x = pk2s(av[0], av[1]); aw.y = pk2s(av[2], av[3]);     *(u32x2*)(lw + 4096 + (size_t)cc * 2) = aw; \
        u32x2 gw; gw.x = pk2s(accg[0], accg[1]); gw.y = pk2s(accg[2], accg[3]); *(u32x2*)(lw + 6144 + (size_t)cc * 2) = gw; } while (0)
    bf16x8 wdA[2], waA[2], wgA[5], wdB[2], waB[2], wgB[5]; f32x4 w0A, a0A, w0B, a0B;
    LORA_LOAD(wdA, waA, wgA, w0A, a0A, nb0);
#pragma unroll 1
    for (int nb = nb0; nb < nb0 + nbn; nb += 2) {
        LORA_LOAD(wdB, waB, wgB, w0B, a0B, nb + 1);
        LORA_COMPUTE(wdA, waA, wgA, w0A, a0A, nb);
        { const int nn = (nb + 2 < nb0 + nbn) ? nb + 2 : nb; LORA_LOAD(wdA, waA, wgA, w0A, a0A, nn); }
        LORA_COMPUTE(wdB, waB, wgB, w0B, a0B, nb + 1);
    }
#undef LORA_LOAD
#undef LORA_COMPUTE
}

__device__ __forceinline__ void phase2(const Params& p, unsigned char* lds) {
    const int tid = otid(), lane = tid & 63, wv = tid >> 6;
    const int G = gridDim.x;
    const bf16_t* P = (const bf16_t*)(p.ws + WS_P);
    bf16_t* attn_o = (bf16_t*)(p.ws + WS_A);
    REP(10) { for (int task = blockIdx.x; task < 256; task += G) { const int wt = task * 8 + wv; lora_wave_unit(p, P, wt >> 1, (wt & 1) * 32, 32, lane); }
      if (wv == 0) for (int m = blockIdx.x; m < 256; m += G) { const int wt = 2048 + (m >> 4); lora_wave_unit(p, P, wt >> 1, (wt & 1) * 32 + (m & 15) * 2, 2, lane); } }
    REP(12) for (int task = blockIdx.x + 254 - ((blockIdx.x + 254) / G) * G; task < 512; task += G) attn_sample_unit(p, P, attn_o, lds, task);
    REP(11) for (int task = blockIdx.x; task < 512; task += G) attn_prompt_unit(lds, P, attn_o, p.in[7], task);
    const long gt = (long)blockIdx.x * NTHREADS + tid, NGT = (long)G * NTHREADS;
    for (long e = gt; e < 2 * 65536; e += NGT) {
        const int which = (int)(e >> 16), r = (int)(e & 65535), bb = r >> 15, s = (r >> 8) & 127, c = r & 255;
        const bf16_t* src = P + (size_t)(bb * SEQ + SEQ - 128 + s) * LDP + (which ? COL_V : COL_K) + c;
        p.out[(which ? O_VWP : O_KWP) + r] = bf2f(*src);
    }
    for (long e = gt; e < (long)(NBATCH + MS) * RW; e += NGT) {
        const int sq = (int)(e / RW), c = (int)(e % RW);
        const int row = (sq < NBATCH) ? sq * SEQ + SEQ - 1 : MP + (sq - NBATCH);
        const float v = bf2f(P[(size_t)row * LDP + COL_R + c]);
        if (sq < NBATCH) p.out[O_SHP + (size_t)sq * RW + c] = v; else p.out[O_SHS + (size_t)(sq - NBATCH) * RW + c] = v;
    }
}

struct PrepRegs { u32x4 cr, ck, cv, pr, pk, pv, a; f32x4 w0, w1; };
__device__ __forceinline__ void unpack8(const u32x4 c, float (&x)[8]) { x[0] = bflo(c.x); x[1] = bfhi(c.x); x[2] = bflo(c.y); x[3] = bfhi(c.y); x[4] = bflo(c.z); x[5] = bfhi(c.z); x[6] = bflo(c.w); x[7] = bfhi(c.w); }

__device__ __forceinline__ void prep_issue(PrepRegs& R, const Params& p, const bf16_t* P, int row, int h, int cb) {
    const bf16_t* q = P + (size_t)row * LDP + h * 64 + cb * 8;
    const bf16_t* qp = (row > 0) ? q - LDP : q;
    R.cr = *(const u32x4*)(q + COL_R); R.ck = *(const u32x4*)(q + COL_RK); R.cv = *(const u32x4*)(q + COL_RV);
    R.pr = *(const u32x4*)(qp + COL_R); R.pk = *(const u32x4*)(qp + COL_RK); R.pv = *(const u32x4*)(qp + COL_RV);
    const unsigned char* lw = (const unsigned char*)p.out + (size_t)row * 8192;
    R.w0 = *(const f32x4*)(lw + (size_t)(h * 64 + cb * 8) * 4); R.w1 = *(const f32x4*)(lw + (size_t)(h * 64 + cb * 8) * 4 + 16);
    R.a = *(const u32x4*)(lw + 4096 + (size_t)(h * 64 + cb * 8) * 2);
}
template <int SUBN, bool WITH_R>
__device__ __forceinline__ void prep_finish(const PrepRegs& R, float* st, const float* cst, int tt, int cb, bool zero_prev, const float* sprev  , int h) {
    float cr[8], ck[8], cv[8], pr[8], pk[8], pv[8], a[8];
    unpack8(R.cr, cr); unpack8(R.ck, ck); unpack8(R.cv, cv); unpack8(R.a, a);
    if (sprev) {
        const float* s0 = sprev + h * 64 + cb * 8;
        const f32x4 r0 = *(const f32x4*)(s0), r1 = *(const f32x4*)(s0 + 4), k0 = *(const f32x4*)(s0 + 1024), k1 = *(const f32x4*)(s0 + 1028), v0 = *(const f32x4*)(s0 + 2048), v1 = *(const f32x4*)(s0 + 2052);
#pragma unroll
        for (int i = 0; i < 4; ++i) { pr[i] = r0[i]; pr[i + 4] = r1[i]; pk[i] = k0[i]; pk[i + 4] = k1[i]; pv[i] = v0[i]; pv[i + 4] = v1[i]; }
    } else { unpack8(R.pr, pr); unpack8(R.pk, pk); unpack8(R.pv, pv);
        if (zero_prev) {
#pragma unroll
            for (int i = 0; i < 8; ++i) { pr[i] = 0.f; pk[i] = 0.f; pv[i] = 0.f; } } }
    const float* c0 = cst + cb * 8;
    float mur[8], muk[8], muv[8], kkc[8], kac[8];
#pragma unroll
    for (int i = 0; i < 8; i += 4) {
        const f32x4 m0 = *(const f32x4*)(c0 + i), m1 = *(const f32x4*)(c0 + 64 + i), m2 = *(const f32x4*)(c0 + 128 + i), m3 = *(const f32x4*)(c0 + 192 + i), m4 = *(const f32x4*)(c0 + 256 + i);
#pragma unroll
        for (int j = 0; j < 4; ++j) { mur[i + j] = m0[j]; muk[i + j] = m1[j]; muv[i + j] = m2[j]; kkc[i + j] = m3[j]; kac[i + j] = m4[j]; }
    }
    const float w[8] = {R.w0[0], R.w0[1], R.w0[2], R.w0[3], R.w1[0], R.w1[1], R.w1[2], R.w1[3]};
    float rs[8], ks[8], vs[8], kr[8]; float ss = 0.f;
#pragma unroll
    for (int i = 0; i < 8; ++i) { rs[i] = cr[i] + (pr[i] - cr[i]) * mur[i]; ks[i] = ck[i] + (pk[i] - ck[i]) * muk[i]; vs[i] = cv[i] + (pv[i] - cv[i]) * muv[i]; kr[i] = ks[i] * kkc[i]; ss += kr[i] * kr[i]; }
    ss = red8(ss);
    const float rn = __builtin_amdgcn_rsqf(fmaxf(ss, 1e-24f));
    float na[8], bb[8], kp[8];
#pragma unroll
    for (int i = 0; i < 8; ++i) { const float kk = kr[i] * rn; na[i] = -kk; bb[i] = kk * a[i]; kp[i] = ks[i] * (1.f + (a[i] - 1.f) * kac[i]); }
    float* d = st + tt * 64 + cb * 8;
#define ST8(arr, x) do { *(f32x4*)(d + (arr) * SUBN * 64) = (f32x4){x[0], x[1], x[2], x[3]}; *(f32x4*)(d + (arr) * SUBN * 64 + 4) = (f32x4){x[4], x[5], x[6], x[7]}; } while (0)
    ST8(0, w); ST8(1, na); ST8(2, bb); ST8(3, kp); ST8(4, vs);
    if (WITH_R) ST8(5, rs);
#undef ST8
}
template <int SUBN, bool WITH_R>
__device__ __forceinline__ void prep_finish_norm(const PrepRegs& R, float* st, const float* cst, int tt, int cb, bool zero_prev, int h, int lane, int wq) {
    const float* sprev = nullptr;
    float cr[8], ck[8], cv[8], pr[8], pk[8], pv[8], a[8];
    unpack8(R.cr, cr); unpack8(R.ck, ck); unpack8(R.cv, cv); unpack8(R.a, a);
    if (sprev) {
        const float* s0 = sprev + h * 64 + cb * 8;
        const f32x4 r0 = *(const f32x4*)(s0), r1 = *(const f32x4*)(s0 + 4), k0 = *(const f32x4*)(s0 + 1024), k1 = *(const f32x4*)(s0 + 1028), v0 = *(const f32x4*)(s0 + 2048), v1 = *(const f32x4*)(s0 + 2052);
#pragma unroll
        for (int i = 0; i < 4; ++i) { pr[i] = r0[i]; pr[i + 4] = r1[i]; pk[i] = k0[i]; pk[i + 4] = k1[i]; pv[i] = v0[i]; pv[i + 4] = v1[i]; }
    } else { unpack8(R.pr, pr); unpack8(R.pk, pk); unpack8(R.pv, pv);
        if (zero_prev) {
#pragma unroll
            for (int i = 0; i < 8; ++i) { pr[i] = 0.f; pk[i] = 0.f; pv[i] = 0.f; } } }
    const float* c0 = cst + cb * 8;
    float mur[8], muk[8], muv[8], kkc[8], kac[8];
#pragma unroll
    for (int i = 0; i < 8; i += 4) {
        const f32x4 m0 = *(const f32x4*)(c0 + i), m1 = *(const f32x4*)(c0 + 64 + i), m2 = *(const f32x4*)(c0 + 128 + i), m3 = *(const f32x4*)(c0 + 192 + i), m4 = *(const f32x4*)(c0 + 256 + i);
#pragma unroll
        for (int j = 0; j < 4; ++j) { mur[i + j] = m0[j]; muk[i + j] = m1[j]; muv[i + j] = m2[j]; kkc[i + j] = m3[j]; kac[i + j] = m4[j]; }
    }
    const float w[8] = {R.w0[0], R.w0[1], R.w0[2], R.w0[3], R.w1[0], R.w1[1], R.w1[2], R.w1[3]};
    float rs[8], ks[8], vs[8], kr[8]; float ss = 0.f;
#pragma unroll
    for (int i = 0; i < 8; ++i) { rs[i] = cr[i] + (pr[i] - cr[i]) * mur[i]; ks[i] = ck[i] + (pk[i] - ck[i]) * muk[i]; vs[i] = cv[i] + (pv[i] - cv[i]) * muv[i]; kr[i] = ks[i] * kkc[i]; ss += kr[i] * kr[i]; }
    ss = red8(ss);
    const float rn = __builtin_amdgcn_rsqf(fmaxf(ss, 1e-24f));
    float na[8], bb[8], kp[8];
#pragma unroll
    for (int i = 0; i < 8; ++i) { const float kk = kr[i] * rn; na[i] = -kk; bb[i] = kk * a[i]; kp[i] = ks[i] * (1.f + (a[i] - 1.f) * kac[i]); }
    float g[8];
#pragma unroll
    for (int i = 0; i < 8; ++i) g[i] = w[i];
#pragma unroll
    for (int d8 = 8; d8 < 64; d8 <<= 1) {
#pragma unroll
        for (int i = 0; i < 8; ++i) { const float t = __shfl_up(g[i], d8); g[i] = (lane >= d8) ? g[i] * t : g[i]; }
    }
    float* tot = st;
    if ((lane >> 3) == 7) { *(f32x4*)(tot + wq * 64 + cb * 8) = (f32x4){g[0], g[1], g[2], g[3]}; *(f32x4*)(tot + wq * 64 + cb * 8 + 4) = (f32x4){g[4], g[5], g[6], g[7]}; }
    __syncthreads();
#pragma unroll
    for (int w_ = 0; w_ < 3; ++w_) {
        if (w_ < wq) { const f32x4 t0 = *(const f32x4*)(tot + w_ * 64 + cb * 8), t1 = *(const f32x4*)(tot + w_ * 64 + cb * 8 + 4);
#pragma unroll
            for (int i = 0; i < 4; ++i) { g[i] *= t0[i]; g[i + 4] *= t1[i]; } }
    }
    if (tt == SUBN - 1) { *(f32x4*)(tot + 256 + cb * 8) = (f32x4){g[0], g[1], g[2], g[3]}; *(f32x4*)(tot + 256 + cb * 8 + 4) = (f32x4){g[4], g[5], g[6], g[7]}; }
#pragma unroll
    for (int i = 0; i < 8; ++i) { const float inv = __builtin_amdgcn_rcpf(g[i]); const float gex = g[i] * __builtin_amdgcn_rcpf(w[i]); na[i] *= gex; bb[i] *= inv; kp[i] *= inv; rs[i] *= g[i]; }
    float* d = st + tt * 64 + cb * 8;
#define ST8(arr, x) do { *(f32x4*)(d + (arr) * SUBN * 64) = (f32x4){x[0], x[1], x[2], x[3]}; *(f32x4*)(d + (arr) * SUBN * 64 + 4) = (f32x4){x[4], x[5], x[6], x[7]}; } while (0)
    ST8(1, na); ST8(2, bb); ST8(3, kp); ST8(4, vs);
    if (WITH_R) ST8(5, rs);
#undef ST8
}

__device__ __forceinline__ void load_cst(const Params& p, float* cst, int h, int utid) {
    const int arr = utid >> 6, j = utid & 63;
    if (arr < 8) { const float* src = (arr < 3) ? p.in[8] + arr * 1024 : (arr == 3) ? p.in[14] : (arr == 4) ? p.in[15] : (arr == 5) ? p.in[16] : (arr == 6) ? p.in[17] : p.in[18];
        cst[arr * 64 + j] = src[h * 64 + j]; }
}

#define LD8S(dst, arr, SUBN) do { const f32x4 _a = *(const f32x4*)(st + ((arr) * SUBN + tt) * 64 + cb * 8), _b = *(const f32x4*)(st + ((arr) * SUBN + tt) * 64 + cb * 8 + 4); \
    dst[0] = (f32x2){_a[0], _a[1]}; dst[1] = (f32x2){_a[2], _a[3]}; dst[2] = (f32x2){_b[0], _b[1]}; dst[3] = (f32x2){_b[2], _b[3]}; } while (0)

constexpr int SUB1 = 64, SUB3 = 32;
__device__ __forceinline__ void scan_pass1_unit(const Params& p, const bf16_t* P, float* PU, float* ldsf, int unit) {
    const int bh = unit / (NCH - 1), ch = unit % (NCH - 1), b = bh >> 4, h = bh & 15;
    const int tid = otid();
    const int rp = tid >> 3, cb = tid & 7;
    float* st = ldsf; float* cst = ldsf + 5 * SUB1 * 64;
    f32x2 S0[4], S1[4];
#pragma unroll
    for (int c = 0; c < 4; ++c) {
        const int c0 = cb * 8 + 2 * c, i0 = 2 * rp - 64, i1 = 2 * rp - 63;
        S0[c] = (f32x2){(c0 == i0) ? 1.f : 0.f, (c0 + 1 == i0) ? 1.f : 0.f};
        S1[c] = (f32x2){(c0 == i1) ? 1.f : 0.f, (c0 + 1 == i1) ? 1.f : 0.f};
    }
    const bool urow = rp < 32;
    const int rowbase = b * SEQ + ch * CHUNK;
    load_cst(p, cst, h, tid);
    PrepRegs R; prep_issue(R, p, P, rowbase + rp, h, cb);
    __syncthreads();
    for (int sc = 0; sc < CHUNK / SUB1; ++sc) {
        prep_finish<SUB1, false>(R, st, cst, rp, cb, ((rowbase + sc * SUB1 + rp) & (SEQ - 1)) == 0, nullptr, h);
        __syncthreads();
        if (sc + 1 < CHUNK / SUB1) prep_issue(R, p, P, rowbase + (sc + 1) * SUB1 + rp, h, cb);
#pragma unroll 2
        for (int tt = 0; tt < SUB1; ++tt) {
            f32x2 w2[4], a2[4], b2[4], k2[4];
            LD8S(w2, 0, SUB1); LD8S(a2, 1, SUB1); LD8S(b2, 2, SUB1); LD8S(k2, 3, SUB1);
            const f32x2 vv = *(const f32x2*)(st + (4 * SUB1 + tt) * 64 + 2 * (rp & 31));
            const float v0 = urow ? vv[0] : 0.f, v1 = urow ? vv[1] : 0.f;
            f32x2 d0 = S0[0] * a2[0], d1 = S1[0] * a2[0];
#pragma unroll
            for (int c = 1; c < 4; ++c) { d0 += S0[c] * a2[c]; d1 += S1[c] * a2[c]; }
            const float sa0 = red8(d0[0] + d0[1]), sa1 = red8(d1[0] + d1[1]);
            const f32x2 sa0v = (f32x2){sa0, sa0}, sa1v = (f32x2){sa1, sa1}, v0v = (f32x2){v0, v0}, v1v = (f32x2){v1, v1};
            if (urow) {
#pragma unroll
                for (int c = 0; c < 4; ++c) {
                    S0[c] = S0[c] * w2[c] + (sa0v * b2[c] + v0v * k2[c]);
                    S1[c] = S1[c] * w2[c] + (sa1v * b2[c] + v1v * k2[c]);
                }
            } else {
#pragma unroll
                for (int c = 0; c < 4; ++c) {
                    S0[c] = S0[c] * w2[c] + sa0v * b2[c];
                    S1[c] = S1[c] * w2[c] + sa1v * b2[c];
                }
            }
        }
        __syncthreads();
    }
    float* dst = PU + ((size_t)(bh * NCH + ch) * 128 + 2 * rp) * 64 + cb * 8;
    *(f32x4*)(dst) = (f32x4){S0[0][0], S0[0][1], S0[1][0], S0[1][1]}; *(f32x4*)(dst + 4) = (f32x4){S0[2][0], S0[2][1], S0[3][0], S0[3][1]};
    *(f32x4*)(dst + 64) = (f32x4){S1[0][0], S1[0][1], S1[1][0], S1[1][1]}; *(f32x4*)(dst + 68) = (f32x4){S1[2][0], S1[2][1], S1[3][0], S1[3][1]};
}

typedef float f32x16 __attribute__((ext_vector_type(16)));
__device__ __forceinline__ float swap_sum32(float x) { const auto rr = __builtin_amdgcn_permlane32_swap(__float_as_uint(x), __float_as_uint(x), false, false); return __uint_as_float(rr[0]) + __uint_as_float(rr[1]); }
constexpr int SUBM = 32;
__device__ __forceinline__ void scan_pass1_pair(const Params& p, const bf16_t* P, float* PU, float* ldsf, int pair) {
    const int tid = otid(), ug = tid >> 8, utid = tid & 255, lane = tid & 63, wq = utid >> 6, l31 = lane & 31, hi = lane >> 5;
    const int unit = pair * 2 + ug;
    const int bh = unit / (NCH - 1), ch = unit % (NCH - 1), b = bh >> 4, h = bh & 15;
    float* st = ldsf + ug * (5 * SUBM * 64 + 512); float* cst = st + 5 * SUBM * 64;
    const int R = wq * 32 + l31;
    const bool urow = wq < 2;
    const int irow = R & 63;
    f32x16 T0, T1;
#pragma unroll
    for (int r = 0; r < 16; ++r) { const int j0 = 8 * (r >> 2) + 4 * hi + (r & 3); T0[r] = (!urow && j0 == irow) ? 1.f : 0.f; T1[r] = (!urow && 32 + j0 == irow) ? 1.f : 0.f; }
    const int rowbase = b * SEQ + ch * CHUNK;
    const int ptt = utid >> 3, pcb = utid & 7;
    load_cst(p, cst, h, utid); load_cst(p, cst, h, utid + 256);
    PrepRegs Rg; prep_issue(Rg, p, P, rowbase + ptt, h, pcb);
    __syncthreads();
    for (int sc = 0; sc < CHUNK / SUBM; ++sc) {
        prep_finish_norm<SUBM, false>(Rg, st, cst, ptt, pcb, ((rowbase + sc * SUBM + ptt) & (SEQ - 1)) == 0, h, lane, wq);
        __syncthreads();
        if (sc + 1 < CHUNK / SUBM) prep_issue(Rg, p, P, rowbase + (sc + 1) * SUBM + ptt, h, pcb);
#pragma unroll 2
        for (int tt = 0; tt < SUBM; ++tt) {
            const float* sA = st + (1 * SUBM + tt) * 64 + 4 * hi;
            f32x16 a0, a1;
#pragma unroll
            for (int q = 0; q < 4; ++q) {
                const f32x4 xa0 = *(const f32x4*)(sA + 8 * q), xa1 = *(const f32x4*)(sA + 32 + 8 * q);
#pragma unroll
                for (int e = 0; e < 4; ++e) { a0[4 * q + e] = xa0[e]; a1[4 * q + e] = xa1[e]; }
            }
            const float areg0 = st[((2 + hi) * SUBM + tt) * 64 + l31], areg1 = st[((2 + hi) * SUBM + tt) * 64 + 32 + l31];
            const float vi = st[(4 * SUBM + tt) * 64 + irow];
            const f32x16 pr = T0 * a0 + T1 * a1;
            const float s01 = ((pr[0] + pr[1]) + (pr[2] + pr[3])) + ((pr[4] + pr[5]) + (pr[6] + pr[7]));
            const float s23 = ((pr[8] + pr[9]) + (pr[10] + pr[11])) + ((pr[12] + pr[13]) + (pr[14] + pr[15]));
            const float sa = swap_sum32(s01 + s23);
            const float breg = hi ? (urow ? vi : 0.f) : sa;
            T0 = __builtin_amdgcn_mfma_f32_32x32x2f32(areg0, breg, T0, 0, 0, 0);
            T1 = __builtin_amdgcn_mfma_f32_32x32x2f32(areg1, breg, T1, 0, 0, 0);
        }
#pragma unroll
        for (int q = 0; q < 4; ++q) {
            const f32x4 g0 = *(const f32x4*)(st + 256 + 8 * q + 4 * hi), g1 = *(const f32x4*)(st + 256 + 32 + 8 * q + 4 * hi);
#pragma unroll
            for (int e = 0; e < 4; ++e) { T0[4 * q + e] *= g0[e]; T1[4 * q + e] *= g1[e]; }
        }
        __syncthreads();
    }
    float* dst = PU + ((size_t)(bh * NCH + ch) * 128 + R) * 64 + 4 * hi;
#pragma unroll
    for (int q = 0; q < 4; ++q) {
        *(f32x4*)(dst + 8 * q) = (f32x4){T0[4 * q], T0[4 * q + 1], T0[4 * q + 2], T0[4 * q + 3]};
        *(f32x4*)(dst + 32 + 8 * q) = (f32x4){T1[4 * q], T1[4 * q + 1], T1[4 * q + 2], T1[4 * q + 3]};
    }
}

__device__ __forceinline__ void scan_pass2_wave(const float* PU, float* SC, int wu, int lane) {
    const int bh = wu >> 6, i = wu & 63;
    float S = 0.f;
    float pc[64], uc;
    { const float* Uc = PU + (size_t)(bh * NCH) * 128 * 64; uc = Uc[i * 64 + lane];
#pragma unroll
      for (int m = 0; m < 64; ++m) pc[m] = Uc[64 * 64 + m * 64 + lane]; }
#pragma unroll 1
    for (int c = 0; c < NCH - 1; ++c) {
        float pn[64], un = 0.f;
        const int cn = (c + 1 < NCH - 1) ? c + 1 : c;
        { const float* Un = PU + (size_t)(bh * NCH + cn) * 128 * 64; un = Un[i * 64 + lane];
#pragma unroll
          for (int m = 0; m < 64; ++m) pn[m] = Un[64 * 64 + m * 64 + lane]; }
        float acc = uc, acc2 = 0.f;
#pragma unroll
        for (int m = 0; m < 64; m += 2) {
            acc += __int_as_float(__builtin_amdgcn_readlane(__float_as_int(S), m)) * pc[m];
            acc2 += __int_as_float(__builtin_amdgcn_readlane(__float_as_int(S), m + 1)) * pc[m + 1];
        }
        S = acc + acc2;
        SC[(size_t)(bh * NCH + c + 1) * 4096 + i * 64 + lane] = S;
        uc = un;
#pragma unroll
        for (int m = 0; m < 64; ++m) pc[m] = pn[m];
    }
}

template <bool IS_S>
__device__ __forceinline__ void scan_pass3_pair(const Params& p, const bf16_t* P, const float* SC, bf16_t* rwkv_o, float* ldsf, int pair) {
    const int tid = otid(), ug = tid >> 8, utid = tid & 255;
    const int unit = pair * 2 + ug;
    int h, row_base; const float* Sinit; float* Sfinal; const float* sprev = nullptr;
    constexpr int ntok = IS_S ? 1 : CHUNK;
    if (!IS_S) { const int bh = unit / NCH, ch = unit % NCH; h = bh & 15; row_base = (bh >> 4) * SEQ + ch * CHUNK;
        Sinit = ch ? SC + (size_t)(bh * NCH + ch) * 4096 : nullptr; Sfinal = (ch == NCH - 1) ? p.out + O_WKVP + (size_t)bh * 4096 : nullptr; }
    else { h = unit & 15; row_base = MP + (unit >> 4); Sinit = p.in[5] + (size_t)unit * 4096; Sfinal = p.out + O_WKVS + (size_t)unit * 4096; sprev = p.in[4] + (size_t)(unit >> 4) * RW; }
    float* st = ldsf + ug * (7 * SUB3 * 64 + 512); float* yb = st + 6 * SUB3 * 64; float* cst = yb + SUB3 * 64;
    const int rp = utid >> 3, cb = utid & 7;
    f32x2 S0[4], S1[4];
    if (Sinit) { const float* s = Sinit + (2 * rp) * 64 + cb * 8;
        const f32x4 a = *(const f32x4*)s, bq = *(const f32x4*)(s + 4), c = *(const f32x4*)(s + 64), d = *(const f32x4*)(s + 68);
        S0[0] = (f32x2){a[0], a[1]}; S0[1] = (f32x2){a[2], a[3]}; S0[2] = (f32x2){bq[0], bq[1]}; S0[3] = (f32x2){bq[2], bq[3]};
        S1[0] = (f32x2){c[0], c[1]}; S1[1] = (f32x2){c[2], c[3]}; S1[2] = (f32x2){d[0], d[1]}; S1[3] = (f32x2){d[2], d[3]}; }
    else {
#pragma unroll
        for (int c = 0; c < 4; ++c) { S0[c] = (f32x2){0.f, 0.f}; S1[c] = (f32x2){0.f, 0.f}; } }
    load_cst(p, cst, h, utid); load_cst(p, cst, h, utid + 256);
    constexpr int nsub = (ntok + SUB3 - 1) / SUB3;
    PrepRegs R;
    if (rp < ntok) prep_issue(R, p, P, row_base + rp, h, cb);
    __syncthreads();
    for (int sc = 0; sc < nsub; ++sc) {
        constexpr int nv = IS_S ? 1 : SUB3;
        const int row0 = row_base + sc * SUB3;
        prep_finish_norm<SUB3, true>(R, st, cst, rp, cb, ((row0 + rp) & (SEQ - 1)) == 0, h, tid & 63, utid >> 6);
        __syncthreads();
        u32x4 greg = (u32x4){0u, 0u, 0u, 0u};
        if (rp < nv) greg = *(const u32x4*)((const unsigned char*)p.out + (size_t)(row0 + rp) * 8192 + 6144 + (size_t)(h * 64 + cb * 8) * 2);
        if (!IS_S && sc + 1 < nsub) prep_issue(R, p, P, row0 + SUB3 + rp, h, cb);
#pragma unroll 2
        for (int tt = 0; tt < nv; ++tt) {
            f32x2 a2[4], b2[4], k2[4], r2[4];
            LD8S(a2, 1, SUB3); LD8S(b2, 2, SUB3); LD8S(k2, 3, SUB3); LD8S(r2, 5, SUB3);
            const f32x2 vv = *(const f32x2*)(st + (4 * SUB3 + tt) * 64 + 2 * rp);
            f32x2 d0 = S0[0] * a2[0], d1 = S1[0] * a2[0];
#pragma unroll
            for (int c = 1; c < 4; ++c) { d0 += S0[c] * a2[c]; d1 += S1[c] * a2[c]; }
            const float sa0 = red8(d0[0] + d0[1]), sa1 = red8(d1[0] + d1[1]);
            const f32x2 sa0v = (f32x2){sa0, sa0}, sa1v = (f32x2){sa1, sa1}, v0v = (f32x2){vv[0], vv[0]}, v1v = (f32x2){vv[1], vv[1]};
#pragma unroll
            for (int c = 0; c < 4; ++c) {
                S0[c] = S0[c] + (sa0v * b2[c] + v0v * k2[c]);
                S1[c] = S1[c] + (sa1v * b2[c] + v1v * k2[c]);
            }
            f32x2 y0 = S0[0] * r2[0], y1 = S1[0] * r2[0];
#pragma unroll
            for (int c = 1; c < 4; ++c) { y0 += S0[c] * r2[c]; y1 += S1[c] * r2[c]; }
            const float ys0 = red8(y0[0] + y0[1]), ys1 = red8(y1[0] + y1[1]);
            if (cb == 0) *(f32x2*)(yb + tt * 64 + 2 * rp) = (f32x2){ys0, ys1};
        }
        { const f32x4 g0 = *(const f32x4*)(st + 256 + cb * 8), g1 = *(const f32x4*)(st + 256 + cb * 8 + 4);
          const f32x2 ga = (f32x2){g0[0], g0[1]}, gb = (f32x2){g0[2], g0[3]}, gc = (f32x2){g1[0], g1[1]}, gd = (f32x2){g1[2], g1[3]};
          S0[0] *= ga; S0[1] *= gb; S0[2] *= gc; S0[3] *= gd; S1[0] *= ga; S1[1] *= gb; S1[2] *= gc; S1[3] *= gd; }
        __syncthreads();
        if (rp < nv) {
            const int tt = rp;
            const f32x4 ya = *(const f32x4*)(yb + tt * 64 + cb * 8), yb4 = *(const f32x4*)(yb + tt * 64 + cb * 8 + 4);
            const float y[8] = {ya[0], ya[1], ya[2], ya[3], yb4[0], yb4[1], yb4[2], yb4[3]};
            float s = 0.f;
#pragma unroll
            for (int i = 0; i < 8; ++i) s += y[i];
            const float mean = red8(s) * (1.f / 64.f);
            float q = 0.f;
#pragma unroll
            for (int i = 0; i < 8; ++i) { const float dd = y[i] - mean; q += dd * dd; }
            const float rstd = rsqrtf(red8(q) * (1.f / 64.f) + GN_EPS);
            const float* sr = st + (5 * SUB3 + tt) * 64 + cb * 8; const float* sk = st + (3 * SUB3 + tt) * 64 + cb * 8; const float* sv = st + (4 * SUB3 + tt) * 64 + cb * 8;
            const float* c5 = cst + 5 * 64 + cb * 8;
            float rkp = 0.f; float vs[8], gw[8], gb[8];
#pragma unroll
            for (int i = 0; i < 8; i += 4) { const f32x4 r4 = *(const f32x4*)(sr + i), k4 = *(const f32x4*)(sk + i), v4 = *(const f32x4*)(sv + i), c4 = *(const f32x4*)(c5 + i), w4 = *(const f32x4*)(c5 + 64 + i), b4 = *(const f32x4*)(c5 + 128 + i);
#pragma unroll
                for (int j = 0; j < 4; ++j) { rkp += r4[j] * k4[j] * c4[j]; vs[i + j] = v4[j]; gw[i + j] = w4[j]; gb[i + j] = b4[j]; } }
            const float rk = red8(rkp);
            float g[8]; unpack8(greg, g);
            float o[8];
#pragma unroll
            for (int i = 0; i < 8; ++i) o[i] = ((y[i] - mean) * rstd * gw[i] + gb[i] + rk * vs[i]) * g[i];
            u32x4 ow; ow.x = pk2(o[0], o[1]); ow.y = pk2(o[2], o[3]); ow.z = pk2(o[4], o[5]); ow.w = pk2(o[6], o[7]);
            *(u32x4*)(rwkv_o + (size_t)(row0 + tt) * AW + h * 64 + cb * 8) = ow;
        }
        __syncthreads();
    }
    if (Sfinal) { float* dst = Sfinal + (2 * rp) * 64 + cb * 8;
        *(f32x4*)(dst) = (f32x4){S0[0][0], S0[0][1], S0[1][0], S0[1][1]}; *(f32x4*)(dst + 4) = (f32x4){S0[2][0], S0[2][1], S0[3][0], S0[3][1]};
        *(f32x4*)(dst + 64) = (f32x4){S1[0][0], S1[0][1], S1[1][0], S1[1][1]}; *(f32x4*)(dst + 68) = (f32x4){S1[2][0], S1[2][1], S1[3][0], S1[3][1]}; }
}

__device__ __forceinline__ void sample_scan_wave(const Params& p, const bf16_t* P, bf16_t* rwkv_o, int wu, int lane) {
    const int b = wu >> 4, h = wu & 15, hj = h * 64 + lane, row = MP + b;
    const bf16_t* q = P + (size_t)row * LDP;
    const float* sp = p.in[4] + (size_t)b * RW;
    const float* mu = p.in[8];
    const float cr = bf2f(q[COL_R + hj]), ck = bf2f(q[COL_RK + hj]), cv = bf2f(q[COL_RV + hj]);
    const float rs = cr + (sp[hj] - cr) * mu[hj], ks = ck + (sp[1024 + hj] - ck) * mu[1024 + hj], vs = cv + (sp[2048 + hj] - cv) * mu[2048 + hj];
    const unsigned char* lw = (const unsigned char*)p.out + (size_t)row * 8192;
    const float w = ((const float*)lw)[hj];
    const float a = bf2f(((const bf16_t*)(lw + 4096))[hj]), g = bf2f(((const bf16_t*)(lw + 6144))[hj]);
    const float* Sin = p.in[5] + (size_t)wu * 4096 + lane * 64;
    float S[64];
#pragma unroll
    for (int c = 0; c < 64; c += 4) { const f32x4 t = *(const f32x4*)(Sin + c); S[c] = t[0]; S[c + 1] = t[1]; S[c + 2] = t[2]; S[c + 3] = t[3]; }
    const float kr = ks * p.in[14][hj];
    const float ss = wave_sum(kr * kr);
    const float kk = kr / fmaxf(sqrtf(ss), 1e-12f);
    const float na = -kk, bb = kk * a, kp = ks * (1.f + (a - 1.f) * p.in[15][hj]);
#define BC(x, c) __int_as_float(__builtin_amdgcn_readlane(__float_as_int(x), (c)))
    float sa0 = 0.f, sa1 = 0.f;
#pragma unroll
    for (int c = 0; c < 64; c += 2) { sa0 += S[c] * BC(na, c); sa1 += S[c + 1] * BC(na, c + 1); }
    const float sa = sa0 + sa1;
    float y0 = 0.f, y1 = 0.f;
#pragma unroll
    for (int c = 0; c < 64; c += 2) {
        S[c] = S[c] * BC(w, c) + (sa * BC(bb, c) + vs * BC(kp, c));
        S[c + 1] = S[c + 1] * BC(w, c + 1) + (sa * BC(bb, c + 1) + vs * BC(kp, c + 1));
        y0 += S[c] * BC(rs, c); y1 += S[c + 1] * BC(rs, c + 1);
    }
#undef BC
    const float y = y0 + y1;
    float* Sout = p.out + O_WKVS + (size_t)wu * 4096 + lane * 64;
#pragma unroll
    for (int c = 0; c < 64; c += 4) *(f32x4*)(Sout + c) = (f32x4){S[c], S[c + 1], S[c + 2], S[c + 3]};
    const float mean = wave_sum(y) * (1.f / 64.f);
    const float dy = y - mean;
    const float var = wave_sum(dy * dy) * (1.f / 64.f);
    const float rk = wave_sum(rs * kp * p.in[16][hj]);
    const float o = (dy * rsqrtf(var + GN_EPS) * p.in[17][hj] + p.in[18][hj] + rk * vs) * g;
    rwkv_o[(size_t)row * AW + hj] = (bf16_t)(pk2(o, 0.f) & 0xffffu);
}

__device__ __forceinline__ void ln_rows(bf16_t* zb, int ldz, const float* g, const float* bt, float* OUTF, int gw, int ngw, int lane) {
    for (int row = gw; row < MREAL; row += ngw) {
        bf16_t* zr = zb + (size_t)row * ldz + lane * 4;
        f32x4 v[8]; float s = 0.f;
#pragma unroll
        for (int j = 0; j < 8; ++j) { const u32x2 w = *(const u32x2*)(zr + j * 256); v[j] = (f32x4){bflo(w.x), bfhi(w.x), bflo(w.y), bfhi(w.y)}; s += (v[j][0] + v[j][1]) + (v[j][2] + v[j][3]); }
        const float mean = wave_sum(s) * (1.f / DM); float s2 = 0.f;
#pragma unroll
        for (int j = 0; j < 8; ++j) { v[j] = v[j] - mean; s2 += (v[j][0] * v[j][0] + v[j][1] * v[j][1]) + (v[j][2] * v[j][2] + v[j][3] * v[j][3]); }
        const float rstd = rsqrtf(wave_sum(s2) * (1.f / DM) + LN_EPS);
#pragma unroll
        for (int j = 0; j < 8; ++j) {
            const f32x4 gv = *(const f32x4*)(g + j * 256 + lane * 4), bv = *(const f32x4*)(bt + j * 256 + lane * 4);
            const f32x4 o = v[j] * rstd * gv + bv;
            if (OUTF) *(f32x4*)(OUTF + (size_t)row * DM + j * 256 + lane * 4) = o;
            else { u32x2 w; w.x = pk2(o[0], o[1]); w.y = pk2(o[2], o[3]); *(u32x2*)(zr + j * 256) = w; }
        }
    }
}

#define XB_TMO      128
#define XB_XCNT(j)  (256  + 64 * (j))
#define XB_XSUB(j)  (1280 + 64 * (j))
#define XB_XGEN(j)  (2304 + 64 * (j))
#define XB_TOP      3328
#define XB_TOPGEN   3392
#define XCD_BAR_WORDS 3456
#define XB_SPIN_CAP (1u << 18)

__device__ __forceinline__ unsigned xb_ld(unsigned* p)              { return __hip_atomic_load(p, __ATOMIC_RELAXED, __HIP_MEMORY_SCOPE_AGENT); }
__device__ __forceinline__ unsigned xb_add(unsigned* p, unsigned v) { return __hip_atomic_fetch_add(p, v, __ATOMIC_RELAXED, __HIP_MEMORY_SCOPE_AGENT); }
__device__ __forceinline__ unsigned xb_xcc_id() { return (unsigned)__builtin_amdgcn_s_getreg((3 << 11) | 20) & 0xFu; }
#define XB_SPIN(cond, bar) do { unsigned _sp = 0; while (cond) { __builtin_amdgcn_s_sleep(1); \
    if ((++_sp & 255u) == 0u) { if (xb_ld(&(bar)[XB_TMO])) break; if (_sp > XB_SPIN_CAP) { atomicAdd(&(bar)[XB_TMO], 1u); break; } } } } while (0)

struct XcdBarrier {
    unsigned* bar; unsigned x;
    volatile PG8_LAS unsigned* st;
};

__device__ __forceinline__ XcdBarrier xcd_barrier_post(unsigned* bar, volatile PG8_LAS unsigned* st) {
    XcdBarrier b; b.bar = bar; b.x = xb_xcc_id(); b.st = st;
    if (threadIdx.x == 0) (void)xb_add(&bar[XB_XCNT(b.x)], 1u);
    return b;
}
__device__ __forceinline__ void xcd_barrier_complete(unsigned* bar, unsigned x, unsigned& nloc, unsigned& nx) {
    const unsigned G = gridDim.x * gridDim.y * gridDim.z;
    unsigned sum, cnt, mine, sp = 0u;
    for (;;) {
        sum = 0u; cnt = 0u; mine = 0u;
#pragma unroll
        for (unsigned j = 0; j < 16; ++j) { const unsigned c = xb_ld(&bar[XB_XCNT(j)]); sum += c; cnt += (c > 0u) ? 1u : 0u; mine = (j == x) ? c : mine; }
        if (sum == G) break;
        __builtin_amdgcn_s_sleep(1);
        if ((++sp & 255u) == 0u) { if (xb_ld(&bar[XB_TMO])) break; if (sp > XB_SPIN_CAP) { atomicAdd(&bar[XB_TMO], 1u); break; } }
    }
    nloc = mine > 0u ? mine : 1u; nx = cnt > 0u ? cnt : 1u;
}

__device__ __forceinline__ void xcd_barrier(const XcdBarrier& b) {
    asm volatile("s_waitcnt vmcnt(0)" ::: "memory");
    __syncthreads();
    if (threadIdx.x == 0) {
        unsigned* bar = b.bar;
        __builtin_amdgcn_s_waitcnt(0);
        unsigned nloc = b.st[0], nx = b.st[1];
        if (nloc == 0u) { xcd_barrier_complete(bar, b.x, nloc, nx); b.st[0] = nloc; b.st[1] = nx; }
        const unsigned old = xb_add(&bar[XB_XSUB(b.x)], 1u);
        const unsigned gen = old / nloc;
        if (old + 1u == (gen + 1u) * nloc) {
            __builtin_amdgcn_fence(__ATOMIC_RELEASE, "agent");
            asm volatile("s_waitcnt vmcnt(0)" ::: "memory");
            const unsigned og = xb_add(&bar[XB_TOP], 1u);
            const unsigned tg = og / nx;
            if (og + 1u == (tg + 1u) * nx) xb_add(&bar[XB_TOPGEN], 1u);
            else XB_SPIN(xb_ld(&bar[XB_TOPGEN]) == tg, bar);
            __builtin_amdgcn_fence(__ATOMIC_ACQUIRE, "agent");
            xb_add(&bar[XB_XGEN(b.x)], 1u);
            asm volatile("s_waitcnt vmcnt(0)" ::: "memory");
        } else {
            XB_SPIN(xb_ld(&bar[XB_XGEN(b.x)]) == gen, bar);
            __builtin_amdgcn_fence(__ATOMIC_ACQUIRE, "agent");
            asm volatile("s_waitcnt vmcnt(0)" ::: "memory");
        }
    }
    __syncthreads();
}

__device__ __forceinline__ void gsync(unsigned* flags, unsigned& gen) {
    asm volatile("s_waitcnt vmcnt(0) lgkmcnt(0)" ::: "memory");
    __syncthreads();
    gen += 1u;
    const unsigned tagk = 0x5EED0000u + gen;
    if (threadIdx.x == 0) {
        __builtin_amdgcn_fence(__ATOMIC_RELEASE, "agent");
        asm volatile("s_waitcnt vmcnt(0)" ::: "memory");
        __hip_atomic_store(flags + 32 * blockIdx.x, tagk, __ATOMIC_RELAXED, __HIP_MEMORY_SCOPE_AGENT);
    }
    if (threadIdx.x < gridDim.x) {
        unsigned* f = flags + 32 * threadIdx.x;
        for (;;) { const unsigned v = __hip_atomic_load(f, __ATOMIC_RELAXED, __HIP_MEMORY_SCOPE_AGENT); if (v == tagk || v == tagk + 1u) break; __builtin_amdgcn_s_sleep(2); }
    }
    __syncthreads();
    __builtin_amdgcn_fence(__ATOMIC_ACQUIRE, "agent");
    asm volatile("s_waitcnt vmcnt(0) lgkmcnt(0)" ::: "memory");
}

#ifndef PROBE_AT
#define PROBE_AT 0
#endif
__device__ __forceinline__ void probe_dump(const Params& p, const bf16_t* a, size_t na, const bf16_t* b, size_t nb) {
    const size_t gt = (size_t)blockIdx.x * NTHREADS + threadIdx.x, NGT = (size_t)gridDim.x * NTHREADS;
    for (size_t e = gt; e < O_END; e += NGT) {
        float v = 0.f;
        if (e < na) v = bf2f(a[e]); else if (e < na + nb) v = bf2f(b[e - na]);
        p.out[e] = v;
    }
}
__global__ void __launch_bounds__(NTHREADS, 2) mega_fwd(Params p) {
    extern __shared__ __attribute__((aligned(16))) unsigned char lds[];
    cg::grid_group grid = cg::this_grid();
    const int G = gridDim.x;
    unsigned char* ws = p.ws;
    bf16_t* Pm = (bf16_t*)(ws + WS_P);
    bf16_t* regA = (bf16_t*)(ws + WS_A);
    bf16_t* rwkv_o = (bf16_t*)(ws + WS_RWO);
    float* PU = (float*)(ws + WS_PU);
    float* SC = (float*)(ws + WS_SC);
    PG8_LAS unsigned char* ldsl = (PG8_LAS unsigned char*)lds;
    float* part = (float*)(ws + WS_PB); unsigned* cnt = (unsigned*)ws; PG8_LAS unsigned* tflag = (PG8_LAS unsigned*)(ldsl + 131072);

    unsigned* bar = (unsigned*)ws + 1024; unsigned gen = 0u;
    unsigned* xbar = (unsigned*)ws + 16384; volatile PG8_LAS unsigned* xst = (volatile PG8_LAS unsigned*)((PG8_LAS unsigned char*)lds + 131072 + 64);
    if (threadIdx.x == 0) { xst[0] = 0u; xst[1] = 0u; }
    __syncthreads();
    grid.sync();
    REP(0) { if (blockIdx.x == 0) { cnt[threadIdx.x] = 0u; for (int i = threadIdx.x; i < XCD_BAR_WORDS; i += NTHREADS) xbar[i] = 0u; }
    phase0(p, lds);
    gsync(bar, gen); }
    XcdBarrier xb = xcd_barrier_post(xbar, xst);
    REP(1) {
        pg8::Gemm g{regA, (const bf16_t*)(ws + WS_WIN), MP, LDP, DM, DM, DM};
        pg8::StaticOrder S; S.init(MP, LDP, G, (int)blockIdx.x);
        pg8::EpiP E{Pm};
        pg8::gemm_phase<pg8::EpiP, pg8::StaticOrder, true, true>(ldsl, g, S, E);
        pg8::Gemm gt{regA, (const bf16_t*)(ws + WS_WIN), MPAD, LDP, 512, DM, DM};
        pg8::TailOrder T{LDP / 256, 4, 4, G, (int)blockIdx.x, MP / 256, 1024, 1024, 0, 0};
        pg8::EpiTail<true, 0, 4> ET{{part, cnt + 0, LDP, 4, tflag, Pm, nullptr, nullptr, 0, nullptr}};
        pg8::gemm_phase<pg8::EpiTail<true, 0, 4>, pg8::TailOrder, true, true>(ldsl, gt, T, ET);
    xcd_barrier(xb); }
    REP(2) { phase2(p, lds);
    xcd_barrier(xb); }
#if PROBE_AT == 2
    { const size_t gt = (size_t)blockIdx.x * NTHREADS + threadIdx.x, NGT = (size_t)gridDim.x * NTHREADS; for (size_t e = gt; e < (size_t)MREAL * 2048; e += NGT) { const unsigned w = __float_as_uint(p.out[e]); p.out[e] = (float)(w & 0xffffu) * 1e-3f + (float)(w >> 16) * 1e-3f + bf2f(regA[e >> 1]); } } return;
#endif
    REP(3) { for (int pr = blockIdx.x; pr < 16 * (NCH - 1); pr += G) scan_pass1_pair(p, Pm, PU, (float*)lds, pr);
    xcd_barrier(xb); }
    REP(4) { const int t4 = otid(); for (int wu = blockIdx.x * 8 + (t4 >> 6); wu < 32 * 64; wu += G * 8) scan_pass2_wave(PU, SC, wu, t4 & 63);
    for (int su = blockIdx.x * 8 + (t4 >> 6); su < MS * 16; su += G * 8) sample_scan_wave(p, Pm, rwkv_o, su, t4 & 63);
    xcd_barrier(xb); }
    REP(5) { for (int pr = blockIdx.x; pr < 32 * NCH / 2; pr += G) scan_pass3_pair<false>(p, Pm, SC, rwkv_o, (float*)lds, pr);
    xcd_barrier(xb); }
#if PROBE_AT == 5
    probe_dump(p, regA, (size_t)MREAL * AW, rwkv_o, (size_t)MREAL * AW); return;
#endif
    {
        pg8::StaticOrder S; S.init(MP, DM, G, (int)blockIdx.x, 8);
        { pg8::Gemm g{regA, (const bf16_t*)(ws + WS_WPA), MP, DM, AW, AW, AW};
          pg8::EpiGateA E{Pm, p.out};
          pg8::gemm_phase<pg8::EpiGateA, pg8::StaticOrder, true, true>(ldsl, g, S, E); }
        asm volatile("s_waitcnt vmcnt(0)" ::: "memory");
        __builtin_amdgcn_fence(__ATOMIC_ACQUIRE, "agent");
        asm volatile("s_waitcnt vmcnt(0)" ::: "memory");
        { pg8::Gemm g{rwkv_o, (const bf16_t*)(ws + WS_WPR), MP, DM, AW, AW, AW};
          pg8::EpiGateB E{Pm, p.out};
          pg8::gemm_phase<pg8::EpiGateB, pg8::StaticOrder, true, true>(ldsl, g, S, E);
          pg8::Gemm gt{regA, (const bf16_t*)(ws + WS_WPA), MPAD, DM, 256, AW, AW};
          pg8::TailOrder T{DM / 256, 4, 8, G, (int)blockIdx.x, MP / 256, 512, 512, (long)MPAD * AW * 2, (long)(WS_WPR - WS_WPA)};
          pg8::EpiTail<false, 1, 4> ET{{part, cnt + 64, DM, 8, tflag, Pm, nullptr, nullptr, 0, nullptr}};
          pg8::gemm_phase<pg8::EpiTail<false, 1, 4>, pg8::TailOrder, true, true>(ldsl, gt, T, ET); }
    }
    xcd_barrier(xb);
    REP(7) {
        pg8::Gemm g{Pm + COL_GA, (const bf16_t*)(ws + WS_WOUT), MP, DM, DM, LDP, DM};
        pg8::StaticOrder S; S.init(MP, DM, G, (int)blockIdx.x);
        pg8::EpiResid E{p.in[0], p.in[1], regA, DM, nullptr};
        pg8::gemm_phase<pg8::EpiResid, pg8::StaticOrder, true, true>(ldsl, g, S, E);
        pg8::Gemm gt{Pm + COL_GA, (const bf16_t*)(ws + WS_WOUT), MPAD, DM, 256, LDP, DM};
        pg8::TailOrder T{DM / 256, 8, 8, G, (int)blockIdx.x, MP / 256, 512, 512, 0, 0};
        pg8::EpiTail<false, 2, 8> ET{{part, cnt + 128, DM, 8, tflag, Pm, p.in[1], regA, DM, nullptr}};
        pg8::gemm_phase<pg8::EpiTail<false, 2, 8>, pg8::TailOrder, true, true>(ldsl, gt, T, ET);
    xcd_barrier(xb); }
    { const int t8 = otid(); ln_rows(regA, DM, p.in[22], p.in[23], nullptr, blockIdx.x * 8 + (t8 >> 6), G * 8, t8 & 63); }
    xcd_barrier(xb);
    REP(9) {
        pg8::Gemm g{regA, (const bf16_t*)(ws + WS_WUP), MP, DFF, DM, DM, DM};
        pg8::StaticOrder S; S.init(MP, DFF, G, (int)blockIdx.x);
        pg8::EpiUp E{Pm};
        pg8::gemm_phase<pg8::EpiUp, pg8::StaticOrder, true, true>(ldsl, g, S, E);
        pg8::Gemm gt{regA, (const bf16_t*)(ws + WS_WUP), MPAD, DFF, 512, DM, DM};
        pg8::TailOrder T{DFF / 256, 4, 4, G, (int)blockIdx.x, MP / 256, 1024, 1024, 0, 0};
        pg8::EpiTail<true, 3, 4> ET{{part, cnt + 192, DFF, 4, tflag, Pm, nullptr, nullptr, 0, nullptr}};
        pg8::gemm_phase<pg8::EpiTail<true, 3, 4>, pg8::TailOrder, true, true>(ldsl, gt, T, ET);
    xcd_barrier(xb); }
    {
        pg8::Gemm g{Pm, (const bf16_t*)(ws + WS_WDN), MP, DM, DFF, DFF, DFF};
        pg8::StaticOrder S; S.init(MP, DM, G, (int)blockIdx.x);
        pg8::EpiResid E{nullptr, nullptr, (bf16_t*)p.out, 2 * DM, regA};
        pg8::gemm_phase<pg8::EpiResid, pg8::StaticOrder, true, true>(ldsl, g, S, E);
        pg8::Gemm gt{Pm, (const bf16_t*)(ws + WS_WDN), MPAD, DM, 512, DFF, DFF};
        pg8::TailOrder T{DM / 256, 16, 16, G, (int)blockIdx.x, MP / 256, 1024, 1024, 0, 0};
        pg8::EpiTail<false, 2, 16> ET{{part, cnt + 256, DM, 16, tflag, Pm, nullptr, (bf16_t*)p.out, 2 * DM, regA}};
        pg8::gemm_phase<pg8::EpiTail<false, 2, 16>, pg8::TailOrder, true, true>(ldsl, gt, T, ET);
    }
    xcd_barrier(xb);
    { const int t11 = otid(); ln_rows((bf16_t*)p.out, 2 * DM, p.in[26], p.in[27], p.out, blockIdx.x * 8 + (t11 >> 6), G * 8, t11 & 63); }
}

extern "C" void kernel_launch(void* const* d_in, const int* in_sizes, int n_in, void* d_out, int out_size, void* d_ws, size_t ws_size, hipStream_t stream) {
    static int grid = 0;
    if (grid == 0) {
        if (n_in != 28 || out_size != (int)O_END || ws_size < WS_END) { fprintf(stderr, "kernel_launch: unexpected shapes: n_in %d out %d ws %zu\n", n_in, out_size, ws_size); grid = -1; return; }
        int dev = 0, cus = 0, per_cu = 0;
        hipGetDevice(&dev);
        hipDeviceGetAttribute(&cus, hipDeviceAttributeMultiprocessorCount, dev);
        hipFuncSetAttribute((const void*)mega_fwd, hipFuncAttributeMaxDynamicSharedMemorySize, LDS_BYTES);
        hipOccupancyMaxActiveBlocksPerMultiprocessor(&per_cu, (const void*)mega_fwd, NTHREADS, LDS_BYTES);
        (void)hipGetLastError();
        if (per_cu < 1) per_cu = 1;
        grid = cus;
        if (grid <= 0) grid = 256;
    }
    if (grid < 0) return;
    Params prm{};
    for (int i = 0; i < 28; ++i) prm.in[i] = (const float*)d_in[i];
    prm.out = (float*)d_out; prm.ws = (unsigned char*)d_ws;
    void* args[] = {&prm};
    hipError_t e = hipLaunchCooperativeKernel((const void*)mega_fwd, dim3(grid), dim3(NTHREADS), args, LDS_BYTES, stream);
    if (e != hipSuccess) fprintf(stderr, "cooperative launch failed: %s (grid %d)\n", hipGetErrorString(e), grid);
}
```
